# Optimizing an MI355X kernel written in HIP

```python
import math
import jax, jax.numpy as jnp
from jax import lax
import numpy as np

D_MODEL = 1024
BATCH = 8
SEQ = 2048
DEPTH = 4

GDN_HEADS = 4
GDN_HEAD_DIM = 128
GDN_CONV = 4
GDN_CHUNK = 64
DSW_HEADS = 4
DSW_HEAD_DIM = 64
DSW_PATTERNS = ((128, 1), (512, 4), (2048, 16))
WIN_BLOCK = 128
DIFF_HEADS = 4
DIFF_QK_DIM = 32
DIFF_V_DIM = 64
ATTN_QBLOCK = 128
D_FF = 2752
FFN_CONV = 3
DEEPNORM_ALPHA = (2 * DEPTH) ** 0.25
DEEPNORM_BETA = (8 * DEPTH) ** -0.25
EPS = 1e-5

GDN_W = GDN_HEADS * GDN_HEAD_DIM
DSW_W = DSW_HEADS * DSW_HEAD_DIM
DIFF_W = DIFF_HEADS * DIFF_V_DIM
MIX_WIDTH = GDN_W + DSW_W + DIFF_W
DIFF_QK_W = DIFF_HEADS * 2 * DIFF_QK_DIM
IN_SPLITS = (3 * GDN_W, GDN_W, GDN_HEADS, GDN_HEADS, 3 * DSW_W, 2 * DIFF_QK_W + DIFF_W)
IN_WIDTH = sum(IN_SPLITS)

kernel_name = "hybrid_gdn_dilated_diff_deepnorm"


def _layer_norm(x, g, b):
    xf = x.astype(jnp.float32)
    mu = jnp.mean(xf, axis=-1, keepdims=True)
    var = jnp.mean(jnp.square(xf - mu), axis=-1, keepdims=True)
    return ((xf - mu) * lax.rsqrt(var + EPS) * g + b).astype(x.dtype)


def _rms_norm(x, w):
    xf = x.astype(jnp.float32)
    return xf * lax.rsqrt(jnp.mean(jnp.square(xf), axis=-1, keepdims=True) + EPS) * w


def _l2norm(x):
    return x * lax.rsqrt(jnp.sum(jnp.square(x), axis=-1, keepdims=True) + 1e-6)


def _heads(a, n_heads):
    B, T, _ = a.shape
    return a.reshape(B, T, n_heads, -1).transpose(0, 2, 1, 3)


def _merge_heads(a):
    B, H, T, D = a.shape
    return a.transpose(0, 2, 1, 3).reshape(B, T, H * D)


def _causal_depthwise_conv(x, w):
    K = w.shape[0]
    T = x.shape[1]
    xp = jnp.pad(x, ((0, 0), (K - 1, 0), (0, 0)))
    y = xp[:, 0:T] * w[0]
    for j in range(1, K):
        y = y + xp[:, j:j + T] * w[j]
    return y


def _chunked_gated_delta_rule(q, k, v, g, beta):
    B, H, T, Dk = q.shape
    Dv = v.shape[-1]
    n = T // GDN_CHUNK
    C = GDN_CHUNK
    rs = lambda a: a.reshape(B, H, n, C, *a.shape[3:])
    q, k, v, g, beta = rs(q), rs(k), rs(v), rs(g), rs(beta)
    g = jnp.cumsum(g, axis=-1)
    idx = jnp.arange(C)
    lower_incl = idx[:, None] >= idx[None, :]
    strict = idx[:, None] > idx[None, :]
    decay = jnp.exp(jnp.where(lower_incl, g[..., :, None] - g[..., None, :], -jnp.inf))
    k_beta = k * beta[..., None]
    m = jnp.where(strict, jnp.einsum('bhncd,bhnsd->bhncs', k_beta, k) * decay, 0.0)
    a_mat = jnp.eye(C, dtype=jnp.float32) + m
    u = lax.linalg.triangular_solve(a_mat, v * beta[..., None], left_side=True, lower=True, unit_diagonal=True)
    w = lax.linalg.triangular_solve(a_mat, k_beta * jnp.exp(g)[..., None], left_side=True, lower=True, unit_diagonal=True)
    qk = jnp.where(lower_incl, jnp.einsum('bhncd,bhnsd->bhncs', q, k) * decay, 0.0)
    g_last = g[..., -1]
    k_tail = k * jnp.exp(g_last[..., None] - g)[..., None]
    q_dec = q * jnp.exp(g)[..., None]

    def step(S, inp):
        q_i, w_i, u_i, qk_i, kt_i, gl_i = inp
        v_new = u_i - jnp.einsum('bhcd,bhde->bhce', w_i, S)
        o = jnp.einsum('bhcd,bhde->bhce', q_i, S) + jnp.einsum('bhcs,bhse->bhce', qk_i, v_new)
        S = S * jnp.exp(gl_i)[..., None, None] + jnp.einsum('bhcd,bhce->bhde', kt_i, v_new)
        return S, o

    xs = tuple(jnp.moveaxis(t, 2, 0) for t in (q_dec, w, u, qk, k_tail, g_last))
    S0 = jnp.zeros((B, H, Dk, Dv), jnp.float32)
    _, o = lax.scan(step, S0, xs)
    return jnp.moveaxis(o, 0, 2).reshape(B, H, T, Dv)


def _gated_deltanet(qkv, z, b, a, conv_w, a_log, dt_bias, norm_w):
    f32 = jnp.float32
    B, T, _ = z.shape
    qkv = jax.nn.silu(_causal_depthwise_conv(qkv, conv_w)).astype(f32)
    q, k, v = (_heads(t, GDN_HEADS) for t in jnp.split(qkv, 3, axis=-1))
    q = _l2norm(q) * GDN_HEAD_DIM ** -0.5
    k = _l2norm(k)
    beta = jax.nn.sigmoid(b.astype(f32)).transpose(0, 2, 1)
    g = (-jnp.exp(a_log.astype(f32)) * jax.nn.softplus(a.astype(f32) + dt_bias.astype(f32))).transpose(0, 2, 1)
    o = _chunked_gated_delta_rule(q, k, v, g, beta).transpose(0, 2, 1, 3)
    zz = z.reshape(B, T, GDN_HEADS, GDN_HEAD_DIM).astype(f32)
    y = _rms_norm(o, norm_w) * jax.nn.silu(zz)
    return y.reshape(B, T, GDN_W).astype(z.dtype)


def _banded_window_attn(q, k, v, window):
    *lead, L, D = q.shape
    nb = -(-L // WIN_BLOCK)
    pad = nb * WIN_BLOCK - L
    lp = [(0, 0)] * len(lead)
    qb = jnp.pad(q, lp + [(0, pad), (0, 0)]).reshape(*lead, nb, WIN_BLOCK, D)

    def kv_blocks(t):
        t = jnp.pad(t, lp + [(WIN_BLOCK, pad), (0, 0)]).reshape(*lead, nb + 1, WIN_BLOCK, D)
        return jnp.concatenate([t[..., :-1, :, :], t[..., 1:, :, :]], axis=-2)

    kb, vb = kv_blocks(k), kv_blocks(v)
    i = jnp.arange(WIN_BLOCK)[:, None]
    j = jnp.arange(2 * WIN_BLOCK)[None, :]
    dist = WIN_BLOCK + i - j
    blk = jnp.arange(nb)[:, None, None]
    valid = (dist >= 0) & (dist <= window) & ((blk > 0) | (j >= WIN_BLOCK))
    s = jnp.einsum('...nqd,...nkd->...nqk', qb, kb).astype(jnp.float32) * D ** -0.5
    s = jnp.where(valid, s, -jnp.inf)
    mx = jnp.max(s, axis=-1, keepdims=True)
    p = jnp.exp(s - mx)
    den = jnp.sum(p, axis=-1, keepdims=True)
    o = jnp.einsum('...nqk,...nkd->...nqd', p, vb.astype(jnp.float32)) / den
    lse = (mx + jnp.log(den))[..., 0]
    o = o.reshape(*lead, nb * WIN_BLOCK, D)[..., :L, :]
    lse = lse.reshape(*lead, nb * WIN_BLOCK)[..., :L]
    return o, lse


def _dilated_window_group(qkv):
    q, k, v = (_heads(t, DSW_HEADS) for t in jnp.split(qkv, 3, axis=-1))
    B, H, T, D = q.shape
    outs, lses = [], []
    for window, dilation in DSW_PATTERNS:
        L = T // dilation
        regroup = lambda t: jnp.swapaxes(t.reshape(B, H, L, dilation, D), 2, 3)
        o, lse = _banded_window_attn(regroup(q), regroup(k), regroup(v), window // dilation)
        outs.append(jnp.swapaxes(o, 2, 3).reshape(B, H, T, D))
        lses.append(jnp.swapaxes(lse, 2, 3).reshape(B, H, T))
    wts = jax.nn.softmax(jnp.stack(lses, axis=0), axis=0)
    o = jnp.sum(wts[..., None] * jnp.stack(outs, axis=0), axis=0)
    return _merge_heads(o).astype(qkv.dtype)


def _diff_attention_group(qkv, lam_vecs, norm_w, lam_init):
    f32 = jnp.float32
    B, T, _ = qkv.shape
    q, k, v = jnp.split(qkv, [DIFF_QK_W, 2 * DIFF_QK_W], axis=-1)
    two_maps = lambda t: t.reshape(B, T, DIFF_HEADS, 2, DIFF_QK_DIM).transpose(0, 2, 3, 1, 4)
    q, k = two_maps(q), two_maps(k)
    v = _heads(v, DIFF_HEADS).astype(f32)
    lv = lam_vecs.astype(f32)
    lam = jnp.exp(jnp.sum(lv[0] * lv[1])) - jnp.exp(jnp.sum(lv[2] * lv[3])) + lam_init
    nq = T // ATTN_QBLOCK
    q_blocks = jnp.moveaxis(q.reshape(B, DIFF_HEADS, 2, nq, ATTN_QBLOCK, DIFF_QK_DIM), 3, 0)
    kpos = jnp.arange(T)
    scale = DIFF_QK_DIM ** -0.5

    def one_block(args):
        q_blk, bi = args
        s = jnp.einsum('bhmqd,bhmkd->bhmqk', q_blk, k).astype(f32) * scale
        qpos = bi * ATTN_QBLOCK + jnp.arange(ATTN_QBLOCK)
        s = jnp.where(kpos[None, :] <= qpos[:, None], s, -jnp.inf)
        p = jax.nn.softmax(s, axis=-1)
        return jnp.einsum('bhqk,bhkd->bhqd', p[:, :, 0] - lam * p[:, :, 1], v)

    o = lax.map(one_block, (q_blocks, jnp.arange(nq)))
    o = jnp.moveaxis(o, 0, 2).reshape(B, DIFF_HEADS, T, DIFF_V_DIM)
    o = _rms_norm(o, norm_w) * (1.0 - lam_init)
    return _merge_heads(o).astype(qkv.dtype)


def _token_mixer(h, w_in, conv_w, a_log, dt_bias, gdn_norm_w, lam_vecs, diff_norm_w, w_out, lam_init):
    proj = h @ w_in
    a_qkv, a_z, a_b, a_dec, b_qkv, c_qkv = jnp.split(proj, np.cumsum(IN_SPLITS)[:-1], axis=-1)
    y_a = _gated_deltanet(a_qkv, a_z, a_b, a_dec, conv_w, a_log, dt_bias, gdn_norm_w)
    y_b = _dilated_window_group(b_qkv)
    y_c = _diff_attention_group(c_qkv, lam_vecs, diff_norm_w, lam_init)
    return jnp.concatenate([y_a, y_b, y_c], axis=-1) @ w_out


def _conv_glu_ffn(h, w_up, conv_w, w_down):
    u = _causal_depthwise_conv(h @ w_up, conv_w)
    gate, val = jnp.split(u, 2, axis=-1)
    return (jax.nn.silu(gate) * val) @ w_down


def setup_inputs(seed: int = 0) -> dict:
    key = jax.random.key(seed)
    ks = jax.random.split(key, 16)
    f32 = jnp.float32
    nrm = lambda k, s: jax.random.normal(k, s, f32)
    x = nrm(ks[0], (BATCH, SEQ, D_MODEL))
    w_in = nrm(ks[1], (DEPTH, D_MODEL, IN_WIDTH)) * D_MODEL ** -0.5
    gdn_conv = nrm(ks[2], (DEPTH, GDN_CONV, 3 * GDN_W)) * GDN_CONV ** -0.5
    gdn_a_log = jnp.log(jax.random.uniform(ks[3], (DEPTH, GDN_HEADS), f32, 1.0, 16.0))
    dt = jnp.exp(jax.random.uniform(ks[4], (DEPTH, GDN_HEADS), f32, math.log(1e-3), math.log(1e-1)))
    gdn_dt_bias = dt + jnp.log(-jnp.expm1(-dt))
    gdn_norm = 1.0 + 0.02 * nrm(ks[5], (DEPTH, GDN_HEAD_DIM))
    diff_lambda = 0.1 * nrm(ks[6], (DEPTH, 4, DIFF_QK_DIM))
    diff_norm = 1.0 + 0.02 * nrm(ks[7], (DEPTH, DIFF_V_DIM))
    w_out = nrm(ks[8], (DEPTH, MIX_WIDTH, D_MODEL)) * MIX_WIDTH ** -0.5 * DEEPNORM_BETA
    ln1_g = 1.0 + 0.02 * nrm(ks[9], (DEPTH, D_MODEL))
    ln1_b = 0.02 * nrm(ks[10], (DEPTH, D_MODEL))
    w_up = nrm(ks[11], (DEPTH, D_MODEL, 2 * D_FF)) * D_MODEL ** -0.5
    ffn_conv = nrm(ks[12], (DEPTH, FFN_CONV, 2 * D_FF)) * FFN_CONV ** -0.5
    w_down = nrm(ks[13], (DEPTH, D_FF, D_MODEL)) * D_FF ** -0.5 * DEEPNORM_BETA
    ln2_g = 1.0 + 0.02 * nrm(ks[14], (DEPTH, D_MODEL))
    ln2_b = 0.02 * nrm(ks[15], (DEPTH, D_MODEL))
    return {"x": x, "w_in": w_in, "gdn_conv": gdn_conv, "gdn_a_log": gdn_a_log,
            "gdn_dt_bias": gdn_dt_bias, "gdn_norm": gdn_norm, "diff_lambda": diff_lambda,
            "diff_norm": diff_norm, "w_out": w_out, "ln1_g": ln1_g, "ln1_b": ln1_b,
            "w_up": w_up, "ffn_conv": ffn_conv, "w_down": w_down, "ln2_g": ln2_g, "ln2_b": ln2_b}


def reference(x, w_in, gdn_conv, gdn_a_log, gdn_dt_bias, gdn_norm, diff_lambda, diff_norm,
              w_out, ln1_g, ln1_b, w_up, ffn_conv, w_down, ln2_g, ln2_b):
    for l in range(DEPTH):
        lam_init = 0.8 - 0.6 * math.exp(-0.3 * l)
        y = _token_mixer(x, w_in[l], gdn_conv[l], gdn_a_log[l], gdn_dt_bias[l], gdn_norm[l],
                         diff_lambda[l], diff_norm[l], w_out[l], lam_init)
        x = _layer_norm(DEEPNORM_ALPHA * x + y, ln1_g[l], ln1_b[l])
        f = _conv_glu_ffn(x, w_up[l], ffn_conv[l], w_down[l])
        x = _layer_norm(DEEPNORM_ALPHA * x + f, ln2_g[l], ln2_b[l])
    return x
```

```cpp
#define MK_ONE_LAUNCH 1
#include <hip/hip_runtime.h>
#include <hip/hip_cooperative_groups.h>
#include <cstdio>
#include <cstdint>
namespace cg = cooperative_groups;
namespace pg8 {
#define PG8_LAS __attribute__((address_space(3)))
typedef unsigned short bf16_t;
typedef short bf16x8 __attribute__((ext_vector_type(8)));
typedef float f32x4 __attribute__((ext_vector_type(4)));
typedef unsigned u32x4 __attribute__((ext_vector_type(4)));
constexpr int BM = 256, BK = 64, HALF = 128, HTB = HALF * BK * 2  , STAGE_BYTES = 8 * HTB, NXCD = 8, WGM = 8;

__host__ __device__ __forceinline__ int lds_byte(int r, int c) { const int st = (r >> 4) * 2 + (c >> 5), rr = r & 15, cc = c & 31, ob = rr * 64 + cc * 2; return st * 1024 + (ob ^ (((ob >> 9) & 1) << 5)); }
__host__ __device__ __forceinline__ void stage_rc(int b, int& R, int& C) { const int st = b / 1024, sb = b % 1024, swz = sb ^ (((sb >> 9) & 1) << 5); R = (st >> 1) * 16 + swz / 64; C = (st & 1) * 32 + (swz % 64) / 2; }
__host__ __device__ __forceinline__ int perm32(int rho) { const int n = rho >> 4, i = rho & 15; return 8 * (i >> 2) + 4 * n + (i & 3); }

struct Unit { int pm, pn; };
struct Gemm { const bf16_t* A; const bf16_t* Bt; int M, N, K; };

struct StaticOrder {
    int nM, nN, nwg, G, c;
    __host__ __device__ void init(int M, int N, int G_, int c_) { nM = M / BM; nN = N / BM; nwg = nM * nN; G = G_; c = c_; }
    __host__ __device__ bool next(int i, Unit& u) const {
        const long L = (long)i * G + c; if (L >= nwg) return false;
        int wgid = (int)L; { const int q = nwg / NXCD, r = nwg % NXCD, xcd = wgid % NXCD, off = wgid / NXCD; wgid = (xcd < r ? xcd * (q + 1) : r * (q + 1) + (xcd - r) * q) + off; }
        const int nig = WGM * nN, gid = wgid / nig, fm = gid * WGM, gsz = (nM - fm) < WGM ? (nM - fm) : WGM;
        u.pm = fm + ((wgid % nig) % gsz); u.pn = (wgid % nig) / gsz; return true;
    }
    __device__ __forceinline__ void a_ready(const Unit&) const {}
    __device__ __forceinline__ void done(const Unit&) const {}
};

__device__ __forceinline__ unsigned cvt_pk_bf16(float lo, float hi) { unsigned r; asm volatile("v_cvt_pk_bf16_f32 %0, %1, %2" : "=v"(r) : "v"(lo), "v"(hi)); return r; }
typedef float f32x2 __attribute__((ext_vector_type(2)));

struct EpiBf16 {
    static constexpr bool PERM = true, AFTER_DRAIN = false;
    bf16_t* O; int ldc;
    __device__ __forceinline__ void operator()(const f32x4 (&acc)[2][2][4][2], const Unit& u, int wr, int wc, int fr, int fq) const {
        const int row0 = u.pm * BM + wr * 64 + fr; const int col0 = u.pn * BM + wc * 32 + 8 * fq;
#pragma unroll
        for (int ai = 0; ai < 2; ++ai)
#pragma unroll
            for (int m = 0; m < 4; ++m) { bf16_t* rowp = O + (size_t)(row0 + ai * HALF + m * 16) * ldc + col0;
#pragma unroll
                for (int bj = 0; bj < 2; ++bj) { const f32x4 v0 = acc[ai][bj][m][0], v1 = acc[ai][bj][m][1];
                    u32x4 w; w.x = cvt_pk_bf16(v0[0], v0[1]); w.y = cvt_pk_bf16(v0[2], v0[3]); w.z = cvt_pk_bf16(v1[0], v1[1]); w.w = cvt_pk_bf16(v1[2], v1[3]);
                    *(u32x4*)(rowp + bj * HALF) = w; } }
    }
};
struct EpiRes {
    static constexpr bool PERM = false, AFTER_DRAIN = false;
    float* X; int ldc; float alpha;
    __device__ __forceinline__ void operator()(const f32x4 (&acc)[2][2][4][2], const Unit& u, int wr, int wc, int fr, int fq) const {
        const int row0 = u.pm * BM + wr * 64 + fr; const int col0 = u.pn * BM + wc * 32 + 4 * fq;
#pragma unroll
        for (int ai = 0; ai < 2; ++ai)
#pragma unroll
            for (int m = 0; m < 4; ++m) { float* rowp = X + (size_t)(row0 + ai * HALF + m * 16) * ldc + col0;
#pragma unroll
                for (int bj = 0; bj < 2; ++bj)
#pragma unroll
                    for (int n = 0; n < 2; ++n) { f32x4* p = (f32x4*)(rowp + bj * HALF + n * 16); const f32x4 x = *p; *p = x * alpha + acc[ai][bj][m][n]; } }
    }
};

template <class Epi, class Sched, bool ALIGN_EPI = false, bool SP2 = false>
__device__ __forceinline__ void gemm_phase(PG8_LAS unsigned char* lds, const Gemm g, const Sched& S, const Epi& E) {
    const int tid = threadIdx.x, wid = __builtin_amdgcn_readfirstlane(tid >> 6), lane = tid & 63, wr = wid >> 2, wc = wid & 3, fr = lane & 15, fq = lane >> 4;
    const int K = g.K, nt = K / BK;
    unsigned voffA[2], voffB[2];
#pragma unroll
    for (int i = 0; i < 2; ++i) { int R, C; stage_rc(tid * 16 + i * 8192, R, C); const int Rb = Epi::PERM ? ((R & ~31) + perm32(R & 31)) : R;
        voffA[i] = (unsigned)(R * K + C) * 2u; voffB[i] = (unsigned)(Rb * K + C) * 2u; }
    const size_t kstep = (size_t)(BK * 2);
    const size_t hstep = (size_t)HALF * K * 2;
    const size_t tstep = 2 * hstep;
    const unsigned ldsw = (unsigned)wid * 1024u;
    const int aoff = lds_byte(wr * 64 + fr, fq * 8), boff = lds_byte(wc * 32 + fr, fq * 8);
#define PG8_SA(b, h) (((b) * 2 + (h)) * HTB)
#define PG8_SB(b, h) ((4 + (b) * 2 + (h)) * HTB)
#define PG8_STAGE(bufoff, gbase, voff) do { _Pragma("unroll") for (int _i = 0; _i < 2; ++_i) \
        __builtin_amdgcn_global_load_lds((const unsigned*)((const char*)(gbase) + (voff)[_i]), (PG8_LAS unsigned*)(lds + (bufoff) + ldsw + _i * 8192), 16, 0, 0); } while (0)
#define PG8_LDA(dst, b, h) do { _Pragma("unroll") for (int m = 0; m < 4; ++m) _Pragma("unroll") for (int k = 0; k < 2; ++k) dst[m][k] = *(const PG8_LAS bf16x8*)(lds + PG8_SA(b, h) + aoff + m * 2048 + k * 1024); } while (0)
#define PG8_LDB(dst, b, h) do { _Pragma("unroll") for (int n = 0; n < 2; ++n) _Pragma("unroll") for (int k = 0; k < 2; ++k) dst[n][k] = *(const PG8_LAS bf16x8*)(lds + PG8_SB(b, h) + boff + n * 2048 + k * 1024); } while (0)
#define PG8_MMA(ai, bj, At, Bt) do { __builtin_amdgcn_s_setprio(1); _Pragma("unroll") for (int m = 0; m < 4; ++m) _Pragma("unroll") for (int n = 0; n < 2; ++n) _Pragma("unroll") for (int k = 0; k < 2; ++k) \
        acc[ai][bj][m][n] = __builtin_amdgcn_mfma_f32_16x16x32_bf16(Bt[n][k], At[m][k], acc[ai][bj][m][n], 0, 0, 0); __builtin_amdgcn_s_setprio(0); } while (0)
#define PG8_WAIT_V(n) asm volatile("s_waitcnt vmcnt(" #n ")" ::: "memory")
#define PG8_WAIT_L(n) asm volatile("s_waitcnt lgkmcnt(" #n ")" ::: "memory")
#define PG8_BAR __builtin_amdgcn_s_barrier()
#define PG8_SCHED __builtin_amdgcn_sched_barrier(0)
    Unit cur, nxt; int ui = 0;
    if (!S.next(0, cur)) return;
    f32x4 acc[2][2][4][2];
#pragma unroll
    for (int a = 0; a < 2; ++a)
#pragma unroll
        for (int b = 0; b < 2; ++b)
#pragma unroll
            for (int m = 0; m < 4; ++m)
#pragma unroll
                for (int n = 0; n < 2; ++n) acc[a][b][m][n] = (f32x4){0.f, 0.f, 0.f, 0.f};
    bf16x8 At[4][2], B0[2][2], B1[2][2];
    const char* cA = (const char*)g.A + (size_t)cur.pm * tstep; const char* cB = (const char*)g.Bt + (size_t)cur.pn * tstep;
    S.a_ready(cur);
    if constexpr (SP2) {
        PG8_STAGE(PG8_SB(0, 0), cB, voffB); PG8_STAGE(PG8_SB(0, 1), cB + hstep, voffB); PG8_STAGE(PG8_SA(0, 0), cA, voffA); PG8_STAGE(PG8_SA(0, 1), cA + hstep, voffA);
        if (wr == 1) PG8_BAR;
        PG8_WAIT_V(2); PG8_BAR;
        PG8_STAGE(PG8_SB(1, 0), cB + kstep, voffB); PG8_STAGE(PG8_SA(1, 0), cA + kstep, voffA); PG8_STAGE(PG8_SB(1, 1), cB + hstep + kstep, voffB);
        PG8_WAIT_V(6); PG8_BAR;
    } else {
        PG8_STAGE(PG8_SB(0, 0), cB, voffB); PG8_STAGE(PG8_SA(0, 0), cA, voffA); PG8_STAGE(PG8_SB(0, 1), cB + hstep, voffB); PG8_STAGE(PG8_SA(0, 1), cA + hstep, voffA);
        if (wr == 1) PG8_BAR;
        PG8_WAIT_V(4); PG8_BAR;
        PG8_STAGE(PG8_SB(1, 0), cB + kstep, voffB); PG8_STAGE(PG8_SA(1, 0), cA + kstep, voffA); PG8_STAGE(PG8_SB(1, 1), cB + hstep + kstep, voffB);
        PG8_WAIT_V(6); PG8_BAR;
    }
    for (;;) {
        const bool has_next = S.next(ui + 1, nxt);
        const char* nA = has_next ? (const char*)g.A + (size_t)nxt.pm * tstep : cA; const char* nB = has_next ? (const char*)g.Bt + (size_t)nxt.pn * tstep : cB;
        for (int t = 0; t < nt; t += 2) {
            const bool last = (t == nt - 2);
            const char* a1 = cA + (size_t)(t + 1) * kstep;
            const char* a2 = last ? nA : cA + (size_t)(t + 2) * kstep; const char* b2 = last ? nB : cB + (size_t)(t + 2) * kstep;
            const char* a3 = a2 + kstep; const char* b3 = b2 + kstep;
            if (last && has_next) S.a_ready(nxt);
            if constexpr (SP2) {
            PG8_LDB(B0, 0, 0); PG8_LDB(B1, 0, 1); PG8_SCHED; PG8_LDA(At, 0, 0); PG8_STAGE(PG8_SA(1, 1), a1 + hstep, voffA);
            PG8_WAIT_V(8); PG8_WAIT_L(0); PG8_BAR; PG8_MMA(0, 0, At, B0); PG8_MMA(0, 1, At, B1); PG8_BAR; PG8_SCHED;
            PG8_LDA(At, 0, 1); PG8_STAGE(PG8_SB(0, 0), b2, voffB); PG8_STAGE(PG8_SB(0, 1), b2 + hstep, voffB); PG8_STAGE(PG8_SA(0, 0), a2, voffA);
            PG8_WAIT_V(8); PG8_WAIT_L(0); PG8_BAR; PG8_MMA(1, 0, At, B0); PG8_MMA(1, 1, At, B1); PG8_BAR; PG8_SCHED;
            PG8_LDB(B0, 1, 0); PG8_LDB(B1, 1, 1); PG8_SCHED; PG8_LDA(At, 1, 0); PG8_STAGE(PG8_SA(0, 1), a2 + hstep, voffA);
            PG8_WAIT_V(8); PG8_WAIT_L(0); PG8_BAR; PG8_MMA(0, 0, At, B0); PG8_MMA(0, 1, At, B1); PG8_BAR; PG8_SCHED;
            PG8_LDA(At, 1, 1); PG8_STAGE(PG8_SB(1, 0), b3, voffB); PG8_STAGE(PG8_SB(1, 1), b3 + hstep, voffB); PG8_STAGE(PG8_SA(1, 0), a3, voffA);
            PG8_WAIT_V(8); PG8_WAIT_L(0); PG8_BAR; PG8_MMA(1, 0, At, B0); PG8_MMA(1, 1, At, B1); PG8_BAR; PG8_SCHED;
            } else {
            PG8_LDB(B0, 0, 0); PG8_SCHED; PG8_LDA(At, 0, 0); PG8_STAGE(PG8_SA(1, 1), a1 + hstep, voffA);
            PG8_WAIT_L(8); PG8_BAR; PG8_WAIT_L(0); PG8_MMA(0, 0, At, B0); PG8_BAR; PG8_SCHED;
            PG8_LDB(B1, 0, 1); PG8_STAGE(PG8_SB(0, 0), b2, voffB);
            PG8_BAR; PG8_WAIT_L(0); PG8_MMA(0, 1, At, B1); PG8_BAR;
            PG8_LDA(At, 0, 1); PG8_STAGE(PG8_SA(0, 0), a2, voffA);
            PG8_BAR; PG8_WAIT_L(0); PG8_MMA(1, 0, At, B0); PG8_BAR; PG8_SCHED;
            PG8_STAGE(PG8_SB(0, 1), b2 + hstep, voffB);
            PG8_WAIT_V(6); PG8_BAR; PG8_MMA(1, 1, At, B1); PG8_BAR;
            PG8_LDB(B0, 1, 0); PG8_SCHED; PG8_LDA(At, 1, 0); PG8_STAGE(PG8_SA(0, 1), a2 + hstep, voffA);
            PG8_WAIT_L(8); PG8_BAR; PG8_WAIT_L(0); PG8_MMA(0, 0, At, B0); PG8_BAR; PG8_SCHED;
            PG8_LDB(B1, 1, 1); PG8_STAGE(PG8_SB(1, 0), b3, voffB);
            PG8_BAR; PG8_WAIT_L(0); PG8_MMA(0, 1, At, B1); PG8_BAR;
            PG8_LDA(At, 1, 1); PG8_STAGE(PG8_SA(1, 0), a3, voffA);
            PG8_BAR; PG8_WAIT_L(0); PG8_MMA(1, 0, At, B0); PG8_BAR; PG8_SCHED;
            PG8_STAGE(PG8_SB(1, 1), b3 + hstep, voffB);
            PG8_WAIT_V(6); PG8_BAR; PG8_MMA(1, 1, At, B1); PG8_BAR;
            }
        }
        if constexpr (ALIGN_EPI) { if (wr == 0) PG8_BAR; }
        if constexpr (!Epi::AFTER_DRAIN) { E(acc, cur, wr, wc, fr, fq); S.done(cur); }
        if (!has_next) break;
#pragma unroll
        for (int a = 0; a < 2; ++a)
#pragma unroll
            for (int b = 0; b < 2; ++b)
#pragma unroll
                for (int m = 0; m < 4; ++m)
#pragma unroll
                    for (int n = 0; n < 2; ++n) acc[a][b][m][n] = (f32x4){0.f, 0.f, 0.f, 0.f};
        cur = nxt; cA = nA; cB = nB; ++ui;
        if constexpr (ALIGN_EPI) { if (wr == 1) PG8_BAR; }
    }
    PG8_WAIT_V(0);
    if constexpr (!ALIGN_EPI) { if (wr == 0) PG8_BAR; }
    PG8_BAR;
    if constexpr (Epi::AFTER_DRAIN) { E.fused(acc, cur, wr, wc, fr, fq, lds, wid, lane); S.done(cur); }
#undef PG8_SA
#undef PG8_SB
#undef PG8_STAGE
#undef PG8_LDA
#undef PG8_LDB
#undef PG8_MMA
#undef PG8_WAIT_V
#undef PG8_WAIT_L
#undef PG8_BAR
#undef PG8_SCHED
}
}

constexpr int BATCH = 8, SEQ = 2048, DM = 1024, M = BATCH * SEQ, DEPTH = 4;
constexpr int NIN = 3584, NIN_SRC = 3592, NUP = 5632, NUP_SRC = 5504, DFF = 2752, KDN = 2816;
constexpr float ALPHA = 1.681792830507429f, LN_EPS = 1e-5f;
constexpr int GQ0 = 0, GK0 = 512, GV0 = 1024, GZ0 = 1536, BQ0 = 2048, BK0 = 2304, BV0 = 2560, CQ0 = 2816, CK0 = 3072, CV0 = 3328;
constexpr int NWAVES = 8, NTHREADS = 512;
constexpr int LDS_BYTES = 147456;
constexpr int PH_PER_LAYER = 14, N_PHASES = 1 + PH_PER_LAYER * DEPTH;

constexpr size_t MiB = 1u << 20;
constexpr size_t WS_CTL = 0;
constexpr size_t WS_WIN = 1 * MiB, WS_WOUT = 8 * MiB, WS_WUP = 10 * MiB, WS_WDN = 21 * MiB;
constexpr size_t WS_BETA = 27 * MiB, WS_G = WS_BETA + 256 * 1024, WS_GC = WS_G + 256 * 1024;
constexpr size_t WS_XB = 28 * MiB, WS_MIX = 60 * MiB, WS_PROJ = 92 * MiB;
constexpr size_t WS_GQ = WS_XB, WS_GK = 204 * MiB, WS_GU = 236 * MiB, WS_GO = WS_GU, WS_GW = 268 * MiB, WS_GQK = 300 * MiB;
constexpr size_t WS_U = 60 * MiB, WS_H = 236 * MiB, WS_END = 324 * MiB;
static_assert(WS_U + (size_t)M * NUP * 2 <= WS_H && WS_H + (size_t)M * KDN * 2 <= WS_END && WS_PROJ + (size_t)M * NIN * 2 <= WS_GK && WS_GQK + 16 * MiB <= WS_END, "ws map");

#define LAS __attribute__((address_space(3)))
typedef unsigned short bf16;
typedef unsigned v4u __attribute__((ext_vector_type(4)));
typedef unsigned v2u __attribute__((ext_vector_type(2)));
typedef float f32x4 __attribute__((ext_vector_type(4)));
#define LDS_WAIT() asm volatile("s_waitcnt lgkmcnt(0)" ::: "memory")

__device__ __forceinline__ unsigned f2bf(float f) { unsigned u = __builtin_bit_cast(unsigned, f); return (u + 0x7fffu + ((u >> 16) & 1u)) >> 16; }
__device__ __forceinline__ unsigned pk2(float lo, float hi) { return f2bf(lo) | (f2bf(hi) << 16); }
__device__ __forceinline__ float bf2f(unsigned short b) { return __builtin_bit_cast(float, (unsigned)b << 16); }
__device__ __forceinline__ float bflo(unsigned w) { return __builtin_bit_cast(float, w << 16); }
__device__ __forceinline__ float bfhi(unsigned w) { return __builtin_bit_cast(float, w & 0xffff0000u); }
__device__ __forceinline__ float wave_sum(float v) {
#pragma unroll
    for (int o = 1; o < 64; o <<= 1) v += __shfl_xor(v, o);
    return v;
}
__device__ __forceinline__ float siluf(float x) { return x / (1.f + __expf(-x)); }
__device__ __forceinline__ float sigmoidf(float x) { return 1.f / (1.f + __expf(-x)); }
__device__ __forceinline__ float softplusf(float x) { return fmaxf(x, 0.f) + log1pf(__expf(-fabsf(x))); }

struct Args { const float* in[16]; float* out; unsigned char* ws; int ph_lo, ph_hi; };

struct Ctx {
    LAS unsigned char* lds; unsigned char* ws; const float* const* in; float* X;
    int tid, lane, wave, gw, ngw, G, bid;
};

__device__ __forceinline__ void transpose_item(const float* W, int src_pitch, int src_col, int k0, bf16* WT, int dst_pitch, int dst_row, LAS float* scr, int lane) {
#pragma unroll 8
    for (int i = 0; i < 32; ++i) { const int kk = 2 * i + (lane >> 5); scr[kk * 33 + (lane & 31)] = W[(size_t)(k0 + kk) * src_pitch + src_col + (lane & 31)]; }
    LDS_WAIT(); asm volatile("" ::: "memory");
    const int c = lane & 7;
#pragma unroll
    for (int j = 0; j < 4; ++j) { const int n = (lane >> 3) + 8 * j; const LAS float* s = scr + (8 * c) * 33 + n;
        v4u o; o.x = pk2(s[0 * 33], s[1 * 33]); o.y = pk2(s[2 * 33], s[3 * 33]); o.z = pk2(s[4 * 33], s[5 * 33]); o.w = pk2(s[6 * 33], s[7 * 33]);
        *(v4u*)(WT + (size_t)(dst_row + n) * dst_pitch + k0 + 8 * c) = o; }
    LDS_WAIT(); asm volatile("" ::: "memory");
}
__device__ __forceinline__ void phase_wconv(const Ctx& C, int l) {
    LAS float* scr = (LAS float*)(C.lds + C.wave * 16384);
    const float* w_in = C.in[1] + (size_t)l * DM * NIN_SRC; const float* w_out = C.in[8] + (size_t)l * DM * DM;
    const float* w_up = C.in[11] + (size_t)l * DM * NUP_SRC; const float* w_dn = C.in[13] + (size_t)l * DFF * DM;
    bf16* WTin = (bf16*)(C.ws + WS_WIN); bf16* WTout = (bf16*)(C.ws + WS_WOUT); bf16* WTup = (bf16*)(C.ws + WS_WUP); bf16* WTdn = (bf16*)(C.ws + WS_WDN);
    constexpr int I_IN = (DM / 64) * (NIN / 32), I_OUT = (DM / 64) * (DM / 32), I_UP = (DM / 64) * (NUP_SRC / 32), I_DN = (DFF / 64) * (DM / 32);
    constexpr int NITEMS = I_IN + I_OUT + I_UP + I_DN;
    for (int it = C.gw; it < NITEMS; it += C.ngw) {
        int r = it;
        if (r < I_IN) { const int nb = r % (NIN / 32), kb = r / (NIN / 32); const int n0 = nb * 32; transpose_item(w_in, NIN_SRC, n0 + (n0 >= 2048 ? 8 : 0), kb * 64, WTin, DM, n0, scr, C.lane); continue; } r -= I_IN;
        if (r < I_OUT) { const int nb = r % (DM / 32), kb = r / (DM / 32); transpose_item(w_out, DM, nb * 32, kb * 64, WTout, DM, nb * 32, scr, C.lane); continue; } r -= I_OUT;
        if (r < I_UP) { const int nb = r % (NUP_SRC / 32), kb = r / (NUP_SRC / 32); transpose_item(w_up, NUP_SRC, nb * 32, kb * 64, WTup, DM, nb * 32, scr, C.lane); continue; } r -= I_UP;
        { const int nb = r % (DM / 32), kb = r / (DM / 32); transpose_item(w_dn, DM, nb * 32, kb * 64, WTdn, KDN, nb * 32, scr, C.lane); }
    }
    const int gt = C.bid * NTHREADS + C.tid, ngt = C.G * NTHREADS;
    for (int i = gt; i < 128 * DM / 8; i += ngt) *(v4u*)(WTup + (size_t)NUP_SRC * DM + (size_t)i * 8) = (v4u){0u, 0u, 0u, 0u};
    for (int i = gt; i < DM * 8; i += ngt) { const int row = i >> 3, c8 = i & 7; *(v4u*)(WTdn + (size_t)row * KDN + DFF + c8 * 8) = (v4u){0u, 0u, 0u, 0u}; }
}

__device__ __forceinline__ void phase_rows(const Ctx& C, int mode, const float* src, const float* gam, const float* bet) {
    bf16* XB = (bf16*)(C.ws + WS_XB);
    for (int m = C.gw; m < M; m += C.ngw) {
        const f32x4* xr = (const f32x4*)(src + (size_t)m * DM) + C.lane;
        f32x4 v[4];
#pragma unroll
        for (int j = 0; j < 4; ++j) v[j] = xr[64 * j];
        if (mode == 1) {
            float s = 0.f;
#pragma unroll
            for (int j = 0; j < 4; ++j) s += (v[j].x + v[j].y) + (v[j].z + v[j].w);
            const float mean = wave_sum(s) * (1.f / DM); float s2 = 0.f;
#pragma unroll
            for (int j = 0; j < 4; ++j) { v[j] = v[j] - mean; s2 += (v[j].x * v[j].x + v[j].y * v[j].y) + (v[j].z * v[j].z + v[j].w * v[j].w); }
            const float rstd = 1.f / sqrtf(wave_sum(s2) * (1.f / DM) + LN_EPS);
#pragma unroll
            for (int j = 0; j < 4; ++j) { const f32x4 gg = ((const f32x4*)gam)[C.lane + 64 * j], bb = ((const f32x4*)bet)[C.lane + 64 * j]; v[j] = v[j] * rstd * gg + bb; }
        }
        f32x4* xo = (f32x4*)(C.X + (size_t)m * DM) + C.lane;
        v2u* bo = (v2u*)(XB + (size_t)m * DM) + C.lane;
#pragma unroll
        for (int j = 0; j < 4; ++j) { xo[64 * j] = v[j]; v2u w; w.x = pk2(v[j].x, v[j].y); w.y = pk2(v[j].z, v[j].w); bo[64 * j] = w; }
    }
}

__device__ __forceinline__ void phase_bg(const Ctx& C, int l) {
    const float* w_in = C.in[1] + (size_t)l * DM * NIN_SRC; const float* a_log = C.in[3] + l * 4; const float* dt_bias = C.in[4] + l * 4;
    float* beta = (float*)(C.ws + WS_BETA); float* g = (float*)(C.ws + WS_G);
    for (int m = C.gw; m < M; m += C.ngw) {
        float acc[8];
#pragma unroll
        for (int i = 0; i < 8; ++i) acc[i] = 0.f;
#pragma unroll
        for (int j = 0; j < 4; ++j) {
            const int k0 = j * 256 + C.lane * 4; const f32x4 xv = *(const f32x4*)(C.X + (size_t)m * DM + k0);
#pragma unroll
            for (int q = 0; q < 4; ++q) { const float xk = xv[q]; const float* wr = w_in + (size_t)(k0 + q) * NIN_SRC + 2048; const f32x4 w0 = *(const f32x4*)wr, w1 = *(const f32x4*)(wr + 4);
                acc[0] += xk * w0.x; acc[1] += xk * w0.y; acc[2] += xk * w0.z; acc[3] += xk * w0.w; acc[4] += xk * w1.x; acc[5] += xk * w1.y; acc[6] += xk * w1.z; acc[7] += xk * w1.w; }
        }
#pragma unroll
        for (int i = 0; i < 8; ++i) acc[i] = wave_sum(acc[i]);
        if (C.lane < 4) {
            const int h = C.lane; float bv = acc[0], av = acc[4];
            if (h == 1) { bv = acc[1]; av = acc[5]; } else if (h == 2) { bv = acc[2]; av = acc[6]; } else if (h == 3) { bv = acc[3]; av = acc[7]; }
            beta[(size_t)m * 4 + h] = sigmoidf(bv);
            g[(size_t)m * 4 + h] = -__expf(a_log[h]) * softplusf(av + dt_bias[h]);
        }
    }
}

__device__ __forceinline__ void phase_gdn_prep(const Ctx& C, int l) {
    const bf16* PROJ = (const bf16*)(C.ws + WS_PROJ); const float* cw = C.in[2] + (size_t)l * 4 * 1536;
    float* GQ = (float*)(C.ws + WS_GQ); float* GK = (float*)(C.ws + WS_GK);
    for (int it = C.gw; it < M * 4; it += C.ngw) {
        const int m = it >> 2, h = it & 3, t = m & (SEQ - 1), b = m >> 11;
        float r[2][2];
#pragma unroll
        for (int s = 0; s < 2; ++s) {
            const int col = s * 512 + h * 128 + C.lane * 2; float a0 = 0.f, a1 = 0.f;
#pragma unroll
            for (int j = 0; j < 4; ++j) { const int tt = t - 3 + j;
                if (tt >= 0) { const unsigned w = *(const unsigned*)(PROJ + (size_t)(m - 3 + j) * NIN + col); a0 += cw[j * 1536 + col] * bflo(w); a1 += cw[j * 1536 + col + 1] * bfhi(w); } }
            r[s][0] = siluf(a0); r[s][1] = siluf(a1);
        }
        const float nq = wave_sum(r[0][0] * r[0][0] + r[0][1] * r[0][1]), nk = wave_sum(r[1][0] * r[1][0] + r[1][1] * r[1][1]);
        const float sq = rsqrtf(nq + 1e-6f) * 0.08838834764831845f, sk = rsqrtf(nk + 1e-6f);
        const size_t o = ((size_t)(b * 4 + h) * SEQ + t) * 128 + C.lane * 2;
        *(float2*)(GQ + o) = make_float2(r[0][0] * sq, r[0][1] * sq);
        *(float2*)(GK + o) = make_float2(r[1][0] * sk, r[1][1] * sk);
    }
}

__device__ __forceinline__ void phase_gdn_chunk(const Ctx& C, int l) {
    const float* cw = C.in[2] + (size_t)l * 4 * 1536;
    LAS float* Ks = (LAS float*)C.lds;
    LAS float* Ms = Ks + 64 * 129;
    LAS float* gcs = Ms + 64 * 65;
    LAS float* bts = gcs + 64;
    LAS float* Qs = bts + 64;
    LAS float* Us = Qs;
    const float* GQ = (const float*)(C.ws + WS_GQ); const float* GK = (const float*)(C.ws + WS_GK); const bf16* PROJ = (const bf16*)(C.ws + WS_PROJ);
    const float* beta = (const float*)(C.ws + WS_BETA); const float* g = (const float*)(C.ws + WS_G);
    float* GC = (float*)(C.ws + WS_GC); float* GU = (float*)(C.ws + WS_GU); float* GW = (float*)(C.ws + WS_GW); float* GQK = (float*)(C.ws + WS_GQK);
    const int tid = C.tid;
    for (int item = C.bid; item < 32 * 32; item += C.G) {
        const int bh = item >> 5, n = item & 31, b = bh >> 2, h = bh & 3;
        const size_t base = ((size_t)bh * SEQ + n * 64) * 128;
        for (int i = tid; i < 64 * 128; i += NTHREADS) { const int c = i >> 7, d = i & 127; Ks[c * 129 + d] = GK[base + i]; Qs[c * 129 + d] = GQ[base + i]; }
        if (tid < 64) { const size_t mi = ((size_t)b * SEQ + n * 64 + tid) * 4 + h; bts[tid] = beta[mi]; gcs[tid] = g[mi]; }
        __syncthreads();
        if (tid == 0) { float s = 0.f; for (int c = 0; c < 64; ++c) { s += gcs[c]; gcs[c] = s; } }
        __syncthreads();
        {
            const int c = tid >> 3, sg = tid & 7;
            float akk[8], aqk[8];
#pragma unroll
            for (int i = 0; i < 8; ++i) { akk[i] = 0.f; aqk[i] = 0.f; }
            for (int d = 0; d < 128; ++d) { const float kc = Ks[c * 129 + d], qc = Qs[c * 129 + d];
#pragma unroll
                for (int i = 0; i < 8; ++i) { const float ks = Ks[(sg + 8 * i) * 129 + d]; akk[i] += kc * ks; aqk[i] += qc * ks; } }
            const float gcc = gcs[c], bc = bts[c];
#pragma unroll
            for (int i = 0; i < 8; ++i) { const int s = sg + 8 * i; const float e = (c >= s) ? __expf(gcc - gcs[s]) : 0.f;
                Ms[c * 65 + s] = (c > s) ? bc * akk[i] * e : 0.f;
                GQK[((size_t)item * 64 + c) * 64 + s] = (c >= s) ? aqk[i] * e : 0.f; }
            if (tid < 64) GC[(size_t)bh * SEQ + n * 64 + tid] = gcs[tid];
        }
        __syncthreads();
        for (int i = tid; i < 64 * 128; i += NTHREADS) { const int c = i >> 7, d = i & 127; const float bc = bts[c];
            const int t = n * 64 + c, col = GV0 + h * 128 + d; const size_t mrow = (size_t)b * SEQ + t; float av = 0.f;
#pragma unroll
            for (int j = 0; j < 4; ++j) { if (t - 3 + j >= 0) av += cw[j * 1536 + col] * bf2f(PROJ[(mrow - 3 + j) * NIN + col]); }
            Us[c * 256 + d] = siluf(av) * bc; Us[c * 256 + 128 + d] = Ks[c * 129 + d] * bc * __expf(gcs[c]); }
        __syncthreads();
        if (tid < 256) {
            for (int c = 1; c < 64; ++c) { float acc = Us[c * 256 + tid];
                for (int s = 0; s < c; ++s) acc -= Ms[c * 65 + s] * Us[s * 256 + tid];
                Us[c * 256 + tid] = acc; }
        }
        __syncthreads();
        for (int i = tid; i < 64 * 128; i += NTHREADS) { const int c = i >> 7, d = i & 127; GU[(size_t)item * 8192 + i] = Us[c * 256 + d]; GW[(size_t)item * 8192 + i] = Us[c * 256 + 128 + d]; }
        __syncthreads();
    }
}

__device__ __forceinline__ void phase_gdn_scan(const Ctx& C) {
    LAS float* Wl = (LAS float*)C.lds;
    LAS float* Ql = Wl + 64 * 129;
    LAS float* Kl = Ql + 64 * 129;
    LAS float* QKl = Kl + 64 * 129;
    LAS float* Ss = QKl + 64 * 65;
    LAS float* Vn = Ss + 128 * 16;
    LAS float* gcl = Vn + 64 * 17;
    const float* GQ = (const float*)(C.ws + WS_GQ); const float* GK = (const float*)(C.ws + WS_GK);
    const float* GC = (const float*)(C.ws + WS_GC); const float* GU = (const float*)(C.ws + WS_GU); const float* GW = (const float*)(C.ws + WS_GW); const float* GQK = (const float*)(C.ws + WS_GQK);
    float* GO = (float*)(C.ws + WS_GO);
    const int tid = C.tid;
    for (int item = C.bid; item < 32 * 8; item += C.G) {
        const int bh = item >> 3, e0 = (item & 7) * 16;
        for (int i = tid; i < 128 * 16; i += NTHREADS) Ss[i] = 0.f;
        for (int n = 0; n < 32; ++n) {
            const size_t ch = (size_t)bh * 32 + n; const size_t base = ((size_t)bh * SEQ + n * 64) * 128;
            if (tid < 64) gcl[tid] = GC[(size_t)bh * SEQ + n * 64 + tid];
            __syncthreads();
            const float gl = gcl[63];
            for (int i = tid; i < 64 * 128; i += NTHREADS) { const int c = i >> 7, d = i & 127; const float gc = gcl[c];
                Wl[c * 129 + d] = GW[ch * 8192 + i]; Ql[c * 129 + d] = GQ[base + i] * __expf(gc); Kl[c * 129 + d] = GK[base + i] * __expf(gl - gc); }
            for (int i = tid; i < 64 * 64; i += NTHREADS) { const int c = i >> 6, s = i & 63; QKl[c * 65 + s] = GQK[ch * 4096 + i]; }
            __syncthreads();
            const int c = tid >> 3, e2 = (tid & 7) * 2;
            {
                float a0 = GU[ch * 8192 + c * 128 + e0 + e2], a1 = GU[ch * 8192 + c * 128 + e0 + e2 + 1];
                for (int d = 0; d < 128; ++d) { const float w = Wl[c * 129 + d]; a0 -= w * Ss[d * 16 + e2]; a1 -= w * Ss[d * 16 + e2 + 1]; }
                Vn[c * 17 + e2] = a0; Vn[c * 17 + e2 + 1] = a1;
            }
            __syncthreads();
            float o0 = 0.f, o1 = 0.f;
            for (int d = 0; d < 128; ++d) { const float q = Ql[c * 129 + d]; o0 += q * Ss[d * 16 + e2]; o1 += q * Ss[d * 16 + e2 + 1]; }
            for (int s = 0; s < 64; ++s) { const float k = QKl[c * 65 + s]; o0 += k * Vn[s * 17 + e2]; o1 += k * Vn[s * 17 + e2 + 1]; }
            *(float2*)(GO + base + (size_t)c * 128 + e0 + e2) = make_float2(o0, o1);
            const int d2 = tid >> 2, e4 = (tid & 3) * 4; const float eg = __expf(gl);
            float s0 = Ss[d2 * 16 + e4] * eg, s1 = Ss[d2 * 16 + e4 + 1] * eg, s2 = Ss[d2 * 16 + e4 + 2] * eg, s3 = Ss[d2 * 16 + e4 + 3] * eg;
            for (int c2 = 0; c2 < 64; ++c2) { const float k = Kl[c2 * 129 + d2]; s0 += k * Vn[c2 * 17 + e4]; s1 += k * Vn[c2 * 17 + e4 + 1]; s2 += k * Vn[c2 * 17 + e4 + 2]; s3 += k * Vn[c2 * 17 + e4 + 3]; }
            __syncthreads();
            Ss[d2 * 16 + e4] = s0; Ss[d2 * 16 + e4 + 1] = s1; Ss[d2 * 16 + e4 + 2] = s2; Ss[d2 * 16 + e4 + 3] = s3;
        }
        __syncthreads();
    }
}

__device__ __forceinline__ void phase_gdn_out(const Ctx& C, int l) {
    const bf16* PROJ = (const bf16*)(C.ws + WS_PROJ); const float* GO = (const float*)(C.ws + WS_GO); bf16* MIX = (bf16*)(C.ws + WS_MIX);
    const float* nw = C.in[5] + l * 128;
    for (int it = C.gw; it < M * 4; it += C.ngw) {
        const int m = it >> 2, h = it & 3, t = m & (SEQ - 1), b = m >> 11;
        const float2 o = *(const float2*)(GO + ((size_t)(b * 4 + h) * SEQ + t) * 128 + C.lane * 2);
        const float ms = wave_sum(o.x * o.x + o.y * o.y) * (1.f / 128.f); const float r = rsqrtf(ms + LN_EPS);
        const unsigned zw = *(const unsigned*)(PROJ + (size_t)m * NIN + GZ0 + h * 128 + C.lane * 2);
        const float y0 = o.x * r * nw[C.lane * 2] * siluf(bflo(zw)), y1 = o.y * r * nw[C.lane * 2 + 1] * siluf(bfhi(zw));
        *(unsigned*)(MIX + (size_t)m * DM + h * 128 + C.lane * 2) = pk2(y0, y1);
    }
}

__device__ __forceinline__ void phase_dsw(const Ctx& C) {
    const bf16* PROJ = (const bf16*)(C.ws + WS_PROJ); bf16* MIX = (bf16*)(C.ws + WS_MIX);
    for (int item = C.gw; item < 32 * 64; item += C.ngw) {
        const int bh = item >> 6, gq = item & 63, b = bh >> 2, h = bh & 3;
        const int t = gq * 32 + (C.lane & 31), half = C.lane >> 5, m = b * SEQ + t;
        float q[64];
        { const v4u* qp = (const v4u*)(PROJ + (size_t)m * NIN + BQ0 + h * 64);
#pragma unroll
          for (int i = 0; i < 8; ++i) { const v4u w = qp[i]; q[8 * i] = bflo(w.x); q[8 * i + 1] = bfhi(w.x); q[8 * i + 2] = bflo(w.y); q[8 * i + 3] = bfhi(w.y); q[8 * i + 4] = bflo(w.z); q[8 * i + 5] = bfhi(w.z); q[8 * i + 6] = bflo(w.w); q[8 * i + 7] = bfhi(w.w); } }
        float o[32];
#pragma unroll
        for (int i = 0; i < 32; ++i) o[i] = 0.f;
        float mrun = -INFINITY, lsum = 0.f;
        for (int p = 0; p < 3; ++p) {
            const int dil = 1 << (2 * p);
            for (int j = 0; j <= 128; ++j) {
                const int tk = t - j * dil;
                if (tk >= 0) {
                    const bf16* row = PROJ + (size_t)(m - j * dil) * NIN;
                    const v4u* kp = (const v4u*)(row + BK0 + h * 64);
                    float s = 0.f;
#pragma unroll
                    for (int i = 0; i < 8; ++i) { const v4u w = kp[i]; s += q[8 * i] * bflo(w.x) + q[8 * i + 1] * bfhi(w.x) + q[8 * i + 2] * bflo(w.y) + q[8 * i + 3] * bfhi(w.y) + q[8 * i + 4] * bflo(w.z) + q[8 * i + 5] * bfhi(w.z) + q[8 * i + 6] * bflo(w.w) + q[8 * i + 7] * bfhi(w.w); }
                    s *= 0.125f;
                    const float mn = fmaxf(mrun, s), a = __expf(mrun - mn), pe = __expf(s - mn);
                    lsum = lsum * a + pe; mrun = mn;
                    const v4u* vp = (const v4u*)(row + BV0 + h * 64 + half * 32);
#pragma unroll
                    for (int i = 0; i < 4; ++i) { const v4u w = vp[i];
                        o[8 * i] = o[8 * i] * a + pe * bflo(w.x); o[8 * i + 1] = o[8 * i + 1] * a + pe * bfhi(w.x); o[8 * i + 2] = o[8 * i + 2] * a + pe * bflo(w.y); o[8 * i + 3] = o[8 * i + 3] * a + pe * bfhi(w.y);
                        o[8 * i + 4] = o[8 * i + 4] * a + pe * bflo(w.z); o[8 * i + 5] = o[8 * i + 5] * a + pe * bfhi(w.z); o[8 * i + 6] = o[8 * i + 6] * a + pe * bflo(w.w); o[8 * i + 7] = o[8 * i + 7] * a + pe * bfhi(w.w); }
                }
            }
        }
        const float inv = 1.f / lsum;
        v4u* op = (v4u*)(MIX + (size_t)m * DM + 512 + h * 64 + half * 32);
#pragma unroll
        for (int i = 0; i < 4; ++i) { v4u w; w.x = pk2(o[8 * i] * inv, o[8 * i + 1] * inv); w.y = pk2(o[8 * i + 2] * inv, o[8 * i + 3] * inv); w.z = pk2(o[8 * i + 4] * inv, o[8 * i + 5] * inv); w.w = pk2(o[8 * i + 6] * inv, o[8 * i + 7] * inv); op[i] = w; }
    }
}

__device__ __forceinline__ void phase_diff(const Ctx& C, int l) {
    const bf16* PROJ = (const bf16*)(C.ws + WS_PROJ); bf16* MIX = (bf16*)(C.ws + WS_MIX);
    const float* lv = C.in[6] + l * 128; const float* nw = C.in[7] + l * 64;
    const float lam_init = 0.8f - 0.6f * expf(-0.3f * (float)l);
    float d01 = 0.f, d23 = 0.f;
    for (int i = 0; i < 32; ++i) { d01 += lv[i] * lv[32 + i]; d23 += lv[64 + i] * lv[96 + i]; }
    const float lam = expf(d01) - expf(d23) + lam_init;
    for (int it = C.bid; it < 256; it += C.G) {
        const int pairIdx = it * 4 + (C.wave & 3), bh = pairIdx >> 5, gg = pairIdx & 31, gq = (C.wave < 4) ? gg : 63 - gg;
        const int b = bh >> 2, h = bh & 3, t = gq * 32 + (C.lane & 31), half = C.lane >> 5, m = b * SEQ + t;
        float q1[32], q2[32];
        { const v4u* qp = (const v4u*)(PROJ + (size_t)m * NIN + CQ0 + h * 64);
#pragma unroll
          for (int i = 0; i < 4; ++i) { const v4u w = qp[i]; q1[8 * i] = bflo(w.x); q1[8 * i + 1] = bfhi(w.x); q1[8 * i + 2] = bflo(w.y); q1[8 * i + 3] = bfhi(w.y); q1[8 * i + 4] = bflo(w.z); q1[8 * i + 5] = bfhi(w.z); q1[8 * i + 6] = bflo(w.w); q1[8 * i + 7] = bfhi(w.w); }
#pragma unroll
          for (int i = 0; i < 4; ++i) { const v4u w = qp[4 + i]; q2[8 * i] = bflo(w.x); q2[8 * i + 1] = bfhi(w.x); q2[8 * i + 2] = bflo(w.y); q2[8 * i + 3] = bfhi(w.y); q2[8 * i + 4] = bflo(w.z); q2[8 * i + 5] = bfhi(w.z); q2[8 * i + 6] = bflo(w.w); q2[8 * i + 7] = bfhi(w.w); } }
        float o1[32], o2[32];
#pragma unroll
        for (int i = 0; i < 32; ++i) { o1[i] = 0.f; o2[i] = 0.f; }
        float m1 = -INFINITY, l1 = 0.f, m2 = -INFINITY, l2 = 0.f;
        const int nkeys = gq * 32 + 32;
        for (int j = 0; j < nkeys; ++j) {
            const bf16* row = PROJ + (size_t)(b * SEQ + j) * NIN;
            const v4u* kp = (const v4u*)(row + CK0 + h * 64);
            float s1 = 0.f, s2 = 0.f;
#pragma unroll
            for (int i = 0; i < 4; ++i) { const v4u w = kp[i]; s1 += q1[8 * i] * bflo(w.x) + q1[8 * i + 1] * bfhi(w.x) + q1[8 * i + 2] * bflo(w.y) + q1[8 * i + 3] * bfhi(w.y) + q1[8 * i + 4] * bflo(w.z) + q1[8 * i + 5] * bfhi(w.z) + q1[8 * i + 6] * bflo(w.w) + q1[8 * i + 7] * bfhi(w.w); }
#pragma unroll
            for (int i = 0; i < 4; ++i) { const v4u w = kp[4 + i]; s2 += q2[8 * i] * bflo(w.x) + q2[8 * i + 1] * bfhi(w.x) + q2[8 * i + 2] * bflo(w.y) + q2[8 * i + 3] * bfhi(w.y) + q2[8 * i + 4] * bflo(w.z) + q2[8 * i + 5] * bfhi(w.z) + q2[8 * i + 6] * bflo(w.w) + q2[8 * i + 7] * bfhi(w.w); }
            if (j <= t) {
                s1 *= 0.17677669529663687f; s2 *= 0.17677669529663687f;
                const float mn1 = fmaxf(m1, s1), a1 = __expf(m1 - mn1), p1 = __expf(s1 - mn1); l1 = l1 * a1 + p1; m1 = mn1;
                const float mn2 = fmaxf(m2, s2), a2 = __expf(m2 - mn2), p2 = __expf(s2 - mn2); l2 = l2 * a2 + p2; m2 = mn2;
                const v4u* vp = (const v4u*)(row + CV0 + h * 64 + half * 32);
#pragma unroll
                for (int i = 0; i < 4; ++i) { const v4u w = vp[i]; float vv[8] = {bflo(w.x), bfhi(w.x), bflo(w.y), bfhi(w.y), bflo(w.z), bfhi(w.z), bflo(w.w), bfhi(w.w)};
#pragma unroll
                    for (int e = 0; e < 8; ++e) { o1[8 * i + e] = o1[8 * i + e] * a1 + p1 * vv[e]; o2[8 * i + e] = o2[8 * i + e] * a2 + p2 * vv[e]; } }
            }
        }
        const float i1 = 1.f / l1, i2 = lam / l2; float ss = 0.f;
#pragma unroll
        for (int i = 0; i < 32; ++i) { o1[i] = o1[i] * i1 - o2[i] * i2; ss += o1[i] * o1[i]; }
        ss += __shfl_xor(ss, 32);
        const float r = rsqrtf(ss * (1.f / 64.f) + LN_EPS) * (1.f - lam_init);
        v4u* op = (v4u*)(MIX + (size_t)m * DM + 768 + h * 64 + half * 32); const float* nwp = nw + half * 32;
#pragma unroll
        for (int i = 0; i < 4; ++i) { v4u w; w.x = pk2(o1[8 * i] * r * nwp[8 * i], o1[8 * i + 1] * r * nwp[8 * i + 1]); w.y = pk2(o1[8 * i + 2] * r * nwp[8 * i + 2], o1[8 * i + 3] * r * nwp[8 * i + 3]);
            w.z = pk2(o1[8 * i + 4] * r * nwp[8 * i + 4], o1[8 * i + 5] * r * nwp[8 * i + 5]); w.w = pk2(o1[8 * i + 6] * r * nwp[8 * i + 6], o1[8 * i + 7] * r * nwp[8 * i + 7]); op[i] = w; }
    }
}

__device__ __forceinline__ void phase_glu(const Ctx& C, int l) {
    const bf16* U = (const bf16*)(C.ws + WS_U); bf16* H = (bf16*)(C.ws + WS_H); const float* cw = C.in[12] + (size_t)l * 3 * NUP_SRC;
    const int gt = C.bid * NTHREADS + C.tid, ngt = C.G * NTHREADS;
    constexpr int GPR = KDN / 8;
    for (int i = gt; i < M * GPR; i += ngt) {
        const int m = i / GPR, gcol = i - m * GPR, j0 = gcol * 8, t = m & (SEQ - 1);
        v4u outw = (v4u){0u, 0u, 0u, 0u};
        if (j0 < DFF) {
            float ag[8], av[8];
#pragma unroll
            for (int e = 0; e < 8; ++e) { ag[e] = 0.f; av[e] = 0.f; }
#pragma unroll
            for (int k = 0; k < 3; ++k) { const int tt = t - 2 + k;
                if (tt >= 0) { const bf16* row = U + (size_t)(m - 2 + k) * NUP; const v4u wg = *(const v4u*)(row + j0), wv = *(const v4u*)(row + DFF + j0);
                    const float* cg = cw + k * NUP_SRC + j0; const float* cv = cg + DFF;
                    const float g8[8] = {bflo(wg.x), bfhi(wg.x), bflo(wg.y), bfhi(wg.y), bflo(wg.z), bfhi(wg.z), bflo(wg.w), bfhi(wg.w)};
                    const float v8[8] = {bflo(wv.x), bfhi(wv.x), bflo(wv.y), bfhi(wv.y), bflo(wv.z), bfhi(wv.z), bflo(wv.w), bfhi(wv.w)};
#pragma unroll
                    for (int e = 0; e < 8; ++e) { ag[e] += cg[e] * g8[e]; av[e] += cv[e] * v8[e]; } } }
            outw.x = pk2(siluf(ag[0]) * av[0], siluf(ag[1]) * av[1]); outw.y = pk2(siluf(ag[2]) * av[2], siluf(ag[3]) * av[3]);
            outw.z = pk2(siluf(ag[4]) * av[4], siluf(ag[5]) * av[5]); outw.w = pk2(siluf(ag[6]) * av[6], siluf(ag[7]) * av[7]);
        }
        *(v4u*)(H + (size_t)m * KDN + j0) = outw;
    }
}

template <bool COOP>
__global__ void __launch_bounds__(NTHREADS, 2) fwd(Args args) {
    extern __shared__ __attribute__((aligned(16))) unsigned char lds_raw[];
    for (int ph = args.ph_lo; ph < args.ph_hi; ++ph) {
        int tid_ = threadIdx.x; asm volatile("" : "+v"(tid_));
        unsigned char* ws_ = args.ws; asm volatile("" : "+s"(ws_));
        float* out_ = args.out; asm volatile("" : "+s"(out_));
        unsigned ldsb_ = 0; asm volatile("" : "+s"(ldsb_));
        Ctx C;
        C.lds = (LAS unsigned char*)lds_raw + ldsb_; C.ws = ws_; C.in = args.in; C.X = out_;
        C.tid = tid_; C.lane = C.tid & 63; C.wave = __builtin_amdgcn_readfirstlane(C.tid >> 6);
        C.G = gridDim.x; C.bid = blockIdx.x; C.gw = C.bid * NWAVES + C.wave; C.ngw = C.G * NWAVES;
        if (ph == 0) { phase_rows(C, 0, args.in[0], nullptr, nullptr); }
        else {
            const int l = (ph - 1) / PH_PER_LAYER, sp = (ph - 1) % PH_PER_LAYER;
#ifndef PHMASK
#define PHMASK 0xffff
#endif
#define PHON(k) ((PHMASK >> (k)) & 1)
            switch (sp) {
            case 0: if (PHON(0)) phase_wconv(C, l); break;
            case 1: case 10: if (PHON(1)) {
                if (sp == 1) phase_bg(C, l);
                pg8::Gemm g; pg8::EpiBf16 E;
                if (sp == 1) { g = pg8::Gemm{(const bf16*)(C.ws + WS_XB), (const bf16*)(C.ws + WS_WIN), M, NIN, DM}; E = pg8::EpiBf16{(bf16*)(C.ws + WS_PROJ), NIN}; }
                else { g = pg8::Gemm{(const bf16*)(C.ws + WS_XB), (const bf16*)(C.ws + WS_WUP), M, NUP, DM}; E = pg8::EpiBf16{(bf16*)(C.ws + WS_U), NUP}; }
                pg8::StaticOrder S; S.init(M, g.N, C.G, C.bid);
                pg8::gemm_phase<pg8::EpiBf16, pg8::StaticOrder, true, false>(C.lds, g, S, E);
            } break;
            case 2: if (PHON(2)) phase_gdn_prep(C, l); break;
            case 3: if (PHON(3)) phase_gdn_chunk(C, l); break;
            case 4: if (PHON(4)) phase_gdn_scan(C); break;
            case 5: if (PHON(5)) phase_gdn_out(C, l); break;
            case 6: if (PHON(6)) phase_dsw(C); break;
            case 7: if (PHON(7)) phase_diff(C, l); break;
            case 8: case 12: if (PHON(8)) {
                pg8::Gemm g;
                if (sp == 8) g = pg8::Gemm{(const bf16*)(C.ws + WS_MIX), (const bf16*)(C.ws + WS_WOUT), M, DM, DM};
                else g = pg8::Gemm{(const bf16*)(C.ws + WS_H), (const bf16*)(C.ws + WS_WDN), M, DM, KDN};
                pg8::EpiRes E{C.X, DM, ALPHA};
                pg8::StaticOrder S; S.init(M, DM, C.G, C.bid);
                pg8::gemm_phase<pg8::EpiRes, pg8::StaticOrder, true, false>(C.lds, g, S, E);
            } break;
            case 9: if (PHON(9)) phase_rows(C, 1, C.X, args.in[9] + l * DM, args.in[10] + l * DM); break;
            case 11: if (PHON(11)) phase_glu(C, l); break;
            case 13: if (PHON(9)) phase_rows(C, 1, C.X, args.in[14] + l * DM, args.in[15] + l * DM); break;
            }
        }
        if (COOP && ph + 1 < args.ph_hi) { cg::this_grid().sync(); }
    }
}

#ifndef MK_ONE_LAUNCH
#define MK_ONE_LAUNCH 0
#endif
extern "C" void kernel_launch(void* const* d_in, const int* in_sizes, int n_in, void* d_out, int out_size, void* d_ws, size_t ws_size, hipStream_t stream) {
    static int grid = 0;
    if (grid == 0) {
        if (n_in != 16 || out_size != M * DM || ws_size < WS_END) { fprintf(stderr, "kernel_launch: unexpected sizes n_in %d out %d ws %zu\n", n_in, out_size, ws_size); grid = -1; return; }
        int dev = 0, cus = 0, per_cu = 0;
        hipGetDevice(&dev); hipDeviceGetAttribute(&cus, hipDeviceAttributeMultiprocessorCount, dev);
        hipFuncSetAttribute((const void*)fwd<true>, hipFuncAttributeMaxDynamicSharedMemorySize, LDS_BYTES);
        hipFuncSetAttribute((const void*)fwd<false>, hipFuncAttributeMaxDynamicSharedMemorySize, LDS_BYTES);
        hipOccupancyMaxActiveBlocksPerMultiprocessor(&per_cu, (const void*)fwd<true>, NTHREADS, LDS_BYTES);
        if (per_cu < 1) per_cu = 1;
        (void)hipGetLastError();
        grid = cus;
    }
    if (grid < 0) return;
    Args a{};
    for (int i = 0; i < 16; ++i) a.in[i] = (const float*)d_in[i];
    a.out = (float*)d_out; a.ws = (unsigned char*)d_ws;
#if MK_ONE_LAUNCH
    a.ph_lo = 0; a.ph_hi = N_PHASES;
    void* kargs[] = {&a};
    hipError_t e = hipLaunchCooperativeKernel((const void*)fwd<true>, dim3(grid), dim3(NTHREADS), kargs, LDS_BYTES, stream);
    if (e != hipSuccess) fprintf(stderr, "cooperative launch failed: %s (grid %d)\n", hipGetErrorString(e), grid);
#else
    for (int ph = 0; ph < N_PHASES; ++ph) { a.ph_lo = ph; a.ph_hi = ph + 1; hipLaunchKernelGGL(fwd<false>, dim3(grid), dim3(NTHREADS), LDS_BYTES, stream, a); }
#endif
}
```

```cpp
#define MK_ONE_LAUNCH 1
#include <hip/hip_runtime.h>
#include <hip/hip_cooperative_groups.h>
#include <cstdio>
#include <cstdint>
namespace cg = cooperative_groups;
namespace pg8 {
#define PG8_LAS __attribute__((address_space(3)))
typedef unsigned short bf16_t;
typedef short bf16x8 __attribute__((ext_vector_type(8)));
typedef float f32x4 __attribute__((ext_vector_type(4)));
typedef unsigned u32x4 __attribute__((ext_vector_type(4)));
constexpr int BM = 256, BK = 64, HALF = 128, HTB = HALF * BK * 2  , STAGE_BYTES = 8 * HTB, NXCD = 8, WGM = 8;

__host__ __device__ __forceinline__ int lds_byte(int r, int c) { const int st = (r >> 4) * 2 + (c >> 5), rr = r & 15, cc = c & 31, ob = rr * 64 + cc * 2; return st * 1024 + (ob ^ (((ob >> 9) & 1) << 5)); }
__host__ __device__ __forceinline__ void stage_rc(int b, int& R, int& C) { const int st = b / 1024, sb = b % 1024, swz = sb ^ (((sb >> 9) & 1) << 5); R = (st >> 1) * 16 + swz / 64; C = (st & 1) * 32 + (swz % 64) / 2; }
__host__ __device__ __forceinline__ int perm32(int rho) { const int n = rho >> 4, i = rho & 15; return 8 * (i >> 2) + 4 * n + (i & 3); }

struct Unit { int pm, pn; };
struct Gemm { const bf16_t* A; const bf16_t* Bt; int M, N, K; };

struct StaticOrder {
    int nM, nN, nwg, G, c;
    __host__ __device__ void init(int M, int N, int G_, int c_) { nM = M / BM; nN = N / BM; nwg = nM * nN; G = G_; c = c_; }
    __host__ __device__ bool next(int i, Unit& u) const {
        const long L = (long)i * G + c; if (L >= nwg) return false;
        int wgid = (int)L; { const int q = nwg / NXCD, r = nwg % NXCD, xcd = wgid % NXCD, off = wgid / NXCD; wgid = (xcd < r ? xcd * (q + 1) : r * (q + 1) + (xcd - r) * q) + off; }
        const int nig = WGM * nN, gid = wgid / nig, fm = gid * WGM, gsz = (nM - fm) < WGM ? (nM - fm) : WGM;
        u.pm = fm + ((wgid % nig) % gsz); u.pn = (wgid % nig) / gsz; return true;
    }
    __device__ __forceinline__ void a_ready(const Unit&) const {}
    __device__ __forceinline__ void done(const Unit&) const {}
};

__device__ __forceinline__ unsigned cvt_pk_bf16(float lo, float hi) { unsigned r; asm volatile("v_cvt_pk_bf16_f32 %0, %1, %2" : "=v"(r) : "v"(lo), "v"(hi)); return r; }
typedef float f32x2 __attribute__((ext_vector_type(2)));

struct EpiBf16 {
    static constexpr bool PERM = true, AFTER_DRAIN = false;
    bf16_t* O; int ldc;
    __device__ __forceinline__ void operator()(const f32x4 (&acc)[2][2][4][2], const Unit& u, int wr, int wc, int fr, int fq) const {
        const int row0 = u.pm * BM + wr * 64 + fr; const int col0 = u.pn * BM + wc * 32 + 8 * fq;
#pragma unroll
        for (int ai = 0; ai < 2; ++ai)
#pragma unroll
            for (int m = 0; m < 4; ++m) { bf16_t* rowp = O + (size_t)(row0 + ai * HALF + m * 16) * ldc + col0;
#pragma unroll
                for (int bj = 0; bj < 2; ++bj) { const f32x4 v0 = acc[ai][bj][m][0], v1 = acc[ai][bj][m][1];
                    u32x4 w; w.x = cvt_pk_bf16(v0[0], v0[1]); w.y = cvt_pk_bf16(v0[2], v0[3]); w.z = cvt_pk_bf16(v1[0], v1[1]); w.w = cvt_pk_bf16(v1[2], v1[3]);
                    *(u32x4*)(rowp + bj * HALF) = w; } }
    }
};
struct EpiRes {
    static constexpr bool PERM = false, AFTER_DRAIN = false;
    float* X; int ldc; float alpha;
    __device__ __forceinline__ void operator()(const f32x4 (&acc)[2][2][4][2], const Unit& u, int wr, int wc, int fr, int fq) const {
        const int row0 = u.pm * BM + wr * 64 + fr; const int col0 = u.pn * BM + wc * 32 + 4 * fq;
#pragma unroll
        for (int ai = 0; ai < 2; ++ai)
#pragma unroll
            for (int m = 0; m < 4; ++m) { float* rowp = X + (size_t)(row0 + ai * HALF + m * 16) * ldc + col0;
#pragma unroll
                for (int bj = 0; bj < 2; ++bj)
#pragma unroll
                    for (int n = 0; n < 2; ++n) { f32x4* p = (f32x4*)(rowp + bj * HALF + n * 16); const f32x4 x = *p; *p = x * alpha + acc[ai][bj][m][n]; }
                asm volatile("" ::: "memory"); }
    }
};

template <class Epi, class Sched, bool ALIGN_EPI = false, bool SP2 = false>
__device__ __forceinline__ void gemm_phase(PG8_LAS unsigned char* lds, const Gemm g, const Sched& S, const Epi& E) {
    int tid_l = threadIdx.x; asm volatile("" : "+v"(tid_l));
    const int tid = tid_l, wid = __builtin_amdgcn_readfirstlane(tid >> 6), lane = tid & 63, wr = wid >> 2, wc = wid & 3, fr = lane & 15, fq = lane >> 4;
    const int K = g.K, nt = K / BK;
    unsigned voffA[2], voffB[2];
#pragma unroll
    for (int i = 0; i < 2; ++i) { int R, C; stage_rc(tid * 16 + i * 8192, R, C); const int Rb = Epi::PERM ? ((R & ~31) + perm32(R & 31)) : R;
        voffA[i] = (unsigned)(R * K + C) * 2u; voffB[i] = (unsigned)(Rb * K + C) * 2u; }
    const size_t kstep = (size_t)(BK * 2);
    const size_t hstep = (size_t)HALF * K * 2;
    const size_t tstep = 2 * hstep;
    const unsigned ldsw = (unsigned)wid * 1024u;
    const int aoff = lds_byte(wr * 64 + fr, fq * 8), boff = lds_byte(wc * 32 + fr, fq * 8);
#define PG8_SA(b, h) (((b) * 2 + (h)) * HTB)
#define PG8_SB(b, h) ((4 + (b) * 2 + (h)) * HTB)
#define PG8_STAGE(bufoff, gbase, voff) do { _Pragma("unroll") for (int _i = 0; _i < 2; ++_i) \
        __builtin_amdgcn_global_load_lds((const unsigned*)((const char*)(gbase) + (voff)[_i]), (PG8_LAS unsigned*)(lds + (bufoff) + ldsw + _i * 8192), 16, 0, 0); } while (0)
#define PG8_LDA(dst, b, h) do { _Pragma("unroll") for (int m = 0; m < 4; ++m) _Pragma("unroll") for (int k = 0; k < 2; ++k) dst[m][k] = *(const PG8_LAS bf16x8*)(lds + PG8_SA(b, h) + aoff + m * 2048 + k * 1024); } while (0)
#define PG8_LDB(dst, b, h) do { _Pragma("unroll") for (int n = 0; n < 2; ++n) _Pragma("unroll") for (int k = 0; k < 2; ++k) dst[n][k] = *(const PG8_LAS bf16x8*)(lds + PG8_SB(b, h) + boff + n * 2048 + k * 1024); } while (0)
#define PG8_MMA(ai, bj, At, Bt) do { __builtin_amdgcn_s_setprio(1); _Pragma("unroll") for (int m = 0; m < 4; ++m) _Pragma("unroll") for (int n = 0; n < 2; ++n) _Pragma("unroll") for (int k = 0; k < 2; ++k) \
        acc[ai][bj][m][n] = __builtin_amdgcn_mfma_f32_16x16x32_bf16(Bt[n][k], At[m][k], acc[ai][bj][m][n], 0, 0, 0); __builtin_amdgcn_s_setprio(0); } while (0)
#define PG8_WAIT_V(n) asm volatile("s_waitcnt vmcnt(" #n ")" ::: "memory")
#define PG8_WAIT_L(n) asm volatile("s_waitcnt lgkmcnt(" #n ")" ::: "memory")
#define PG8_BAR __builtin_amdgcn_s_barrier()
#define PG8_SCHED __builtin_amdgcn_sched_barrier(0)
    Unit cur, nxt; int ui = 0;
    if (!S.next(0, cur)) return;
    f32x4 acc[2][2][4][2];
#pragma unroll
    for (int a = 0; a < 2; ++a)
#pragma unroll
        for (int b = 0; b < 2; ++b)
#pragma unroll
            for (int m = 0; m < 4; ++m)
#pragma unroll
                for (int n = 0; n < 2; ++n) acc[a][b][m][n] = (f32x4){0.f, 0.f, 0.f, 0.f};
    bf16x8 At[4][2], B0[2][2], B1[2][2];
    const char* cA = (const char*)g.A + (size_t)cur.pm * tstep; const char* cB = (const char*)g.Bt + (size_t)cur.pn * tstep;
    S.a_ready(cur);
    if constexpr (SP2) {
        PG8_STAGE(PG8_SB(0, 0), cB, voffB); PG8_STAGE(PG8_SB(0, 1), cB + hstep, voffB); PG8_STAGE(PG8_SA(0, 0), cA, voffA); PG8_STAGE(PG8_SA(0, 1), cA + hstep, voffA);
        if (wr == 1) PG8_BAR;
        PG8_WAIT_V(2); PG8_BAR;
        PG8_STAGE(PG8_SB(1, 0), cB + kstep, voffB); PG8_STAGE(PG8_SA(1, 0), cA + kstep, voffA); PG8_STAGE(PG8_SB(1, 1), cB + hstep + kstep, voffB);
        PG8_WAIT_V(6); PG8_BAR;
    } else {
        PG8_STAGE(PG8_SB(0, 0), cB, voffB); PG8_STAGE(PG8_SA(0, 0), cA, voffA); PG8_STAGE(PG8_SB(0, 1), cB + hstep, voffB); PG8_STAGE(PG8_SA(0, 1), cA + hstep, voffA);
        if (wr == 1) PG8_BAR;
        PG8_WAIT_V(4); PG8_BAR;
        PG8_STAGE(PG8_SB(1, 0), cB + kstep, voffB); PG8_STAGE(PG8_SA(1, 0), cA + kstep, voffA); PG8_STAGE(PG8_SB(1, 1), cB + hstep + kstep, voffB);
        PG8_WAIT_V(6); PG8_BAR;
    }
    for (;;) {
        const bool has_next = S.next(ui + 1, nxt);
        const char* nA = has_next ? (const char*)g.A + (size_t)nxt.pm * tstep : cA; const char* nB = has_next ? (const char*)g.Bt + (size_t)nxt.pn * tstep : cB;
        for (int t = 0; t < nt; t += 2) {
            const bool last = (t == nt - 2);
            const char* a1 = cA + (size_t)(t + 1) * kstep;
            const char* a2 = last ? nA : cA + (size_t)(t + 2) * kstep; const char* b2 = last ? nB : cB + (size_t)(t + 2) * kstep;
            const char* a3 = a2 + kstep; const char* b3 = b2 + kstep;
            if (last && has_next) S.a_ready(nxt);
            if constexpr (SP2) {
            PG8_LDB(B0, 0, 0); PG8_LDB(B1, 0, 1); PG8_SCHED; PG8_LDA(At, 0, 0); PG8_STAGE(PG8_SA(1, 1), a1 + hstep, voffA);
            PG8_WAIT_V(8); PG8_WAIT_L(0); PG8_BAR; PG8_MMA(0, 0, At, B0); PG8_MMA(0, 1, At, B1); PG8_BAR; PG8_SCHED;
            PG8_LDA(At, 0, 1); PG8_STAGE(PG8_SB(0, 0), b2, voffB); PG8_STAGE(PG8_SB(0, 1), b2 + hstep, voffB); PG8_STAGE(PG8_SA(0, 0), a2, voffA);
            PG8_WAIT_V(8); PG8_WAIT_L(0); PG8_BAR; PG8_MMA(1, 0, At, B0); PG8_MMA(1, 1, At, B1); PG8_BAR; PG8_SCHED;
            PG8_LDB(B0, 1, 0); PG8_LDB(B1, 1, 1); PG8_SCHED; PG8_LDA(At, 1, 0); PG8_STAGE(PG8_SA(0, 1), a2 + hstep, voffA);
            PG8_WAIT_V(8); PG8_WAIT_L(0); PG8_BAR; PG8_MMA(0, 0, At, B0); PG8_MMA(0, 1, At, B1); PG8_BAR; PG8_SCHED;
            PG8_LDA(At, 1, 1); PG8_STAGE(PG8_SB(1, 0), b3, voffB); PG8_STAGE(PG8_SB(1, 1), b3 + hstep, voffB); PG8_STAGE(PG8_SA(1, 0), a3, voffA);
            PG8_WAIT_V(8); PG8_WAIT_L(0); PG8_BAR; PG8_MMA(1, 0, At, B0); PG8_MMA(1, 1, At, B1); PG8_BAR; PG8_SCHED;
            } else {
            PG8_LDB(B0, 0, 0); PG8_SCHED; PG8_LDA(At, 0, 0); PG8_STAGE(PG8_SA(1, 1), a1 + hstep, voffA);
            PG8_WAIT_L(8); PG8_BAR; PG8_WAIT_L(0); PG8_MMA(0, 0, At, B0); PG8_BAR; PG8_SCHED;
            PG8_LDB(B1, 0, 1); PG8_STAGE(PG8_SB(0, 0), b2, voffB);
            PG8_BAR; PG8_WAIT_L(0); PG8_MMA(0, 1, At, B1); PG8_BAR;
            PG8_LDA(At, 0, 1); PG8_STAGE(PG8_SA(0, 0), a2, voffA);
            PG8_BAR; PG8_WAIT_L(0); PG8_MMA(1, 0, At, B0); PG8_BAR; PG8_SCHED;
            PG8_STAGE(PG8_SB(0, 1), b2 + hstep, voffB);
            PG8_WAIT_V(6); PG8_BAR; PG8_MMA(1, 1, At, B1); PG8_BAR;
            PG8_LDB(B0, 1, 0); PG8_SCHED; PG8_LDA(At, 1, 0); PG8_STAGE(PG8_SA(0, 1), a2 + hstep, voffA);
            PG8_WAIT_L(8); PG8_BAR; PG8_WAIT_L(0); PG8_MMA(0, 0, At, B0); PG8_BAR; PG8_SCHED;
            PG8_LDB(B1, 1, 1); PG8_STAGE(PG8_SB(1, 0), b3, voffB);
            PG8_BAR; PG8_WAIT_L(0); PG8_MMA(0, 1, At, B1); PG8_BAR;
            PG8_LDA(At, 1, 1); PG8_STAGE(PG8_SA(1, 0), a3, voffA);
            PG8_BAR; PG8_WAIT_L(0); PG8_MMA(1, 0, At, B0); PG8_BAR; PG8_SCHED;
            PG8_STAGE(PG8_SB(1, 1), b3 + hstep, voffB);
            PG8_WAIT_V(6); PG8_BAR; PG8_MMA(1, 1, At, B1); PG8_BAR;
            }
        }
        if constexpr (ALIGN_EPI) { if (wr == 0) PG8_BAR; }
        if constexpr (!Epi::AFTER_DRAIN) { E(acc, cur, wr, wc, fr, fq); S.done(cur); }
        if (!has_next) break;
#pragma unroll
        for (int a = 0; a < 2; ++a)
#pragma unroll
            for (int b = 0; b < 2; ++b)
#pragma unroll
                for (int m = 0; m < 4; ++m)
#pragma unroll
                    for (int n = 0; n < 2; ++n) acc[a][b][m][n] = (f32x4){0.f, 0.f, 0.f, 0.f};
        cur = nxt; cA = nA; cB = nB; ++ui;
        if constexpr (ALIGN_EPI) { if (wr == 1) PG8_BAR; }
    }
    PG8_WAIT_V(0);
    if constexpr (!ALIGN_EPI) { if (wr == 0) PG8_BAR; }
    PG8_BAR;
    if constexpr (Epi::AFTER_DRAIN) { E.fused(acc, cur, wr, wc, fr, fq, lds, wid, lane); S.done(cur); }
#undef PG8_SA
#undef PG8_SB
#undef PG8_STAGE
#undef PG8_LDA
#undef PG8_LDB
#undef PG8_MMA
#undef PG8_WAIT_V
#undef PG8_WAIT_L
#undef PG8_BAR
#undef PG8_SCHED
}
}

#ifndef MK_ONE_LAUNCH
#define MK_ONE_LAUNCH 0
#endif
constexpr int BATCH = 8, SEQ = 2048, DM = 1024, M = BATCH * SEQ, DEPTH = 4;
constexpr int NIN = 3584, NIN_SRC = 3592, NUP = 5632, NUP_SRC = 5504, DFF = 2752, KDN = 2816;
constexpr float ALPHA = 1.681792830507429f, LN_EPS = 1e-5f;
constexpr int GQ0 = 0, GK0 = 512, GV0 = 1024, GZ0 = 1536, BQ0 = 2048, BK0 = 2304, BV0 = 2560, CQ0 = 2816, CK0 = 3072, CV0 = 3328;
constexpr int NWAVES = 8, NTHREADS = 512;
constexpr int LDS_BYTES = 147456;
constexpr int PH_PER_LAYER = 14, N_PHASES = 1 + PH_PER_LAYER * DEPTH;

constexpr size_t MiB = 1u << 20;
constexpr size_t WS_CTL = 0, CTL_ZERO_BYTES = 65536;
constexpr int CW_BAR = 4096, MISC_OFF = 131072;
constexpr size_t WS_WIN = 1 * MiB, WS_WOUT = 8 * MiB, WS_WUP = 10 * MiB, WS_WDN = 21 * MiB;
constexpr size_t WS_BETA = 27 * MiB, WS_G = WS_BETA + 256 * 1024, WS_GC = WS_G + 256 * 1024;
constexpr size_t WS_XB = 28 * MiB, WS_MIX = 60 * MiB, WS_PROJ = 92 * MiB;
constexpr size_t WS_GQ = WS_XB, WS_GK = 204 * MiB, WS_GU = 236 * MiB, WS_GO = WS_GU, WS_GW = 268 * MiB, WS_GQK = 300 * MiB;
constexpr size_t WS_NW = 204 * MiB, WS_QD = 220 * MiB, WS_KT = 268 * MiB, WS_QKB = 284 * MiB, WS_EGL = WS_GC;
constexpr size_t WS_U = 60 * MiB, WS_H = 236 * MiB, WS_END = 324 * MiB;
static_assert(WS_U + (size_t)M * NUP * 2 <= WS_H && WS_H + (size_t)M * KDN * 2 <= WS_END && WS_PROJ + (size_t)M * NIN * 2 <= WS_GK && WS_GQK + 16 * MiB <= WS_END, "ws map");

#define LAS __attribute__((address_space(3)))
typedef unsigned short bf16;
typedef unsigned v4u __attribute__((ext_vector_type(4)));
typedef unsigned v2u __attribute__((ext_vector_type(2)));
typedef float f32x4 __attribute__((ext_vector_type(4)));
#define LDS_WAIT() asm volatile("s_waitcnt lgkmcnt(0)" ::: "memory")

__device__ __forceinline__ unsigned f2bf(float f) { unsigned u = __builtin_bit_cast(unsigned, f); return (u + 0x7fffu + ((u >> 16) & 1u)) >> 16; }
__device__ __forceinline__ unsigned pk2(float lo, float hi) { return f2bf(lo) | (f2bf(hi) << 16); }
__device__ __forceinline__ float bf2f(unsigned short b) { return __builtin_bit_cast(float, (unsigned)b << 16); }
__device__ __forceinline__ float bflo(unsigned w) { return __builtin_bit_cast(float, w << 16); }
__device__ __forceinline__ float bfhi(unsigned w) { return __builtin_bit_cast(float, w & 0xffff0000u); }
__device__ __forceinline__ float wave_sum(float v) {
#pragma unroll
    for (int o = 1; o < 64; o <<= 1) v += __shfl_xor(v, o);
    return v;
}
__device__ __forceinline__ float siluf(float x) { return x / (1.f + __expf(-x)); }
__device__ __forceinline__ float sigmoidf(float x) { return 1.f / (1.f + __expf(-x)); }
__device__ __forceinline__ float softplusf(float x) { return fmaxf(x, 0.f) + log1pf(__expf(-fabsf(x))); }

struct Args { const float* in[16]; float* out; unsigned char* ws; int ph_lo, ph_hi; };

struct Ctx {
    LAS unsigned char* lds; unsigned char* ws; const float* const* in; float* X;
    int tid, lane, wave, gw, ngw, G, bid;
};

__device__ __forceinline__ void transpose_item(const float* W, int src_pitch, int src_col, int k0, bf16* WT, int dst_pitch, int dst_row, LAS float* scr, int lane) {
#pragma unroll 8
    for (int i = 0; i < 32; ++i) { const int kk = 2 * i + (lane >> 5); scr[kk * 33 + (lane & 31)] = W[(size_t)(k0 + kk) * src_pitch + src_col + (lane & 31)]; }
    LDS_WAIT(); asm volatile("" ::: "memory");
    const int c = lane & 7;
#pragma unroll
    for (int j = 0; j < 4; ++j) { const int n = (lane >> 3) + 8 * j; const LAS float* s = scr + (8 * c) * 33 + n;
        v4u o; o.x = pk2(s[0 * 33], s[1 * 33]); o.y = pk2(s[2 * 33], s[3 * 33]); o.z = pk2(s[4 * 33], s[5 * 33]); o.w = pk2(s[6 * 33], s[7 * 33]);
        *(v4u*)(WT + (size_t)(dst_row + n) * dst_pitch + k0 + 8 * c) = o; }
    LDS_WAIT(); asm volatile("" ::: "memory");
}
__device__ __forceinline__ void phase_wconv(const Ctx& C, int l) {
    LAS float* scr = (LAS float*)(C.lds + C.wave * 16384);
    const float* w_in = C.in[1] + (size_t)l * DM * NIN_SRC; const float* w_out = C.in[8] + (size_t)l * DM * DM;
    const float* w_up = C.in[11] + (size_t)l * DM * NUP_SRC; const float* w_dn = C.in[13] + (size_t)l * DFF * DM;
    bf16* WTin = (bf16*)(C.ws + WS_WIN); bf16* WTout = (bf16*)(C.ws + WS_WOUT); bf16* WTup = (bf16*)(C.ws + WS_WUP); bf16* WTdn = (bf16*)(C.ws + WS_WDN);
    constexpr int I_IN = (DM / 64) * (NIN / 32), I_OUT = (DM / 64) * (DM / 32), I_UP = (DM / 64) * (NUP_SRC / 32), I_DN = (DFF / 64) * (DM / 32);
    constexpr int NITEMS = I_IN + I_OUT + I_UP + I_DN;
    for (int it = C.gw; it < NITEMS; it += C.ngw) {
        int r = it;
        if (r < I_IN) { const int nb = r % (NIN / 32), kb = r / (NIN / 32); const int n0 = nb * 32; transpose_item(w_in, NIN_SRC, n0 + (n0 >= 2048 ? 8 : 0), kb * 64, WTin, DM, n0, scr, C.lane); continue; } r -= I_IN;
        if (r < I_OUT) { const int nb = r % (DM / 32), kb = r / (DM / 32); transpose_item(w_out, DM, nb * 32, kb * 64, WTout, DM, nb * 32, scr, C.lane); continue; } r -= I_OUT;
        if (r < I_UP) { const int nb = r % (NUP_SRC / 32), kb = r / (NUP_SRC / 32); transpose_item(w_up, NUP_SRC, nb * 32, kb * 64, WTup, DM, nb * 32, scr, C.lane); continue; } r -= I_UP;
        { const int nb = r % (DM / 32), kb = r / (DM / 32); transpose_item(w_dn, DM, nb * 32, kb * 64, WTdn, KDN, nb * 32, scr, C.lane); }
    }
    const int gt = C.bid * NTHREADS + C.tid, ngt = C.G * NTHREADS;
    for (int i = gt; i < 128 * DM / 8; i += ngt) *(v4u*)(WTup + (size_t)NUP_SRC * DM + (size_t)i * 8) = (v4u){0u, 0u, 0u, 0u};
    for (int i = gt; i < DM * 8; i += ngt) { const int row = i >> 3, c8 = i & 7; *(v4u*)(WTdn + (size_t)row * KDN + DFF + c8 * 8) = (v4u){0u, 0u, 0u, 0u}; }
}

__device__ __forceinline__ void phase_rows(const Ctx& C, int mode, const float* src, const float* gam, const float* bet) {
    bf16* XB = (bf16*)(C.ws + WS_XB);
    for (int m = C.gw; m < M; m += C.ngw) {
        const f32x4* xr = (const f32x4*)(src + (size_t)m * DM) + C.lane;
        f32x4 v[4];
#pragma unroll
        for (int j = 0; j < 4; ++j) v[j] = xr[64 * j];
        if (mode == 1) {
            float s = 0.f;
#pragma unroll
            for (int j = 0; j < 4; ++j) s += (v[j].x + v[j].y) + (v[j].z + v[j].w);
            const float mean = wave_sum(s) * (1.f / DM); float s2 = 0.f;
#pragma unroll
            for (int j = 0; j < 4; ++j) { v[j] = v[j] - mean; s2 += (v[j].x * v[j].x + v[j].y * v[j].y) + (v[j].z * v[j].z + v[j].w * v[j].w); }
            const float rstd = 1.f / sqrtf(wave_sum(s2) * (1.f / DM) + LN_EPS);
#pragma unroll
            for (int j = 0; j < 4; ++j) { const f32x4 gg = ((const f32x4*)gam)[C.lane + 64 * j], bb = ((const f32x4*)bet)[C.lane + 64 * j]; v[j] = v[j] * rstd * gg + bb; }
        }
        f32x4* xo = (f32x4*)(C.X + (size_t)m * DM) + C.lane;
        v2u* bo = (v2u*)(XB + (size_t)m * DM) + C.lane;
#pragma unroll
        for (int j = 0; j < 4; ++j) { xo[64 * j] = v[j]; v2u w; w.x = pk2(v[j].x, v[j].y); w.y = pk2(v[j].z, v[j].w); bo[64 * j] = w; }
    }
}

__device__ __forceinline__ void phase_bg(const Ctx& C, int l) {
    const float* w_in = C.in[1] + (size_t)l * DM * NIN_SRC; const float* a_log = C.in[3] + l * 4; const float* dt_bias = C.in[4] + l * 4;
    float* beta = (float*)(C.ws + WS_BETA); float* g = (float*)(C.ws + WS_G);
    for (int m = C.gw; m < M; m += C.ngw) {
        float acc[8];
#pragma unroll
        for (int i = 0; i < 8; ++i) acc[i] = 0.f;
#pragma unroll
        for (int j = 0; j < 4; ++j) {
            const int k0 = j * 256 + C.lane * 4; const f32x4 xv = *(const f32x4*)(C.X + (size_t)m * DM + k0);
#pragma unroll
            for (int q = 0; q < 4; ++q) { const float xk = xv[q]; const float* wr = w_in + (size_t)(k0 + q) * NIN_SRC + 2048; const f32x4 w0 = *(const f32x4*)wr, w1 = *(const f32x4*)(wr + 4);
                acc[0] += xk * w0.x; acc[1] += xk * w0.y; acc[2] += xk * w0.z; acc[3] += xk * w0.w; acc[4] += xk * w1.x; acc[5] += xk * w1.y; acc[6] += xk * w1.z; acc[7] += xk * w1.w; }
        }
#pragma unroll
        for (int i = 0; i < 8; ++i) acc[i] = wave_sum(acc[i]);
        if (C.lane < 4) {
            const int h = C.lane; float bv = acc[0], av = acc[4];
            if (h == 1) { bv = acc[1]; av = acc[5]; } else if (h == 2) { bv = acc[2]; av = acc[6]; } else if (h == 3) { bv = acc[3]; av = acc[7]; }
            beta[(size_t)m * 4 + h] = sigmoidf(bv);
            g[(size_t)m * 4 + h] = -__expf(a_log[h]) * softplusf(av + dt_bias[h]);
        }
    }
}

__device__ __forceinline__ void phase_gdn_prep(const Ctx& C, int l) {
    const bf16* PROJ = (const bf16*)(C.ws + WS_PROJ); const float* cw = C.in[2] + (size_t)l * 4 * 1536;
    float* GQ = (float*)(C.ws + WS_GQ); float* GK = (float*)(C.ws + WS_GK);
    for (int it = C.gw; it < M * 4; it += C.ngw) {
        const int m = it >> 2, h = it & 3, t = m & (SEQ - 1), b = m >> 11;
        float r[2][2];
#pragma unroll
        for (int s = 0; s < 2; ++s) {
            const int col = s * 512 + h * 128 + C.lane * 2; float a0 = 0.f, a1 = 0.f;
#pragma unroll
            for (int j = 0; j < 4; ++j) { const int tt = t - 3 + j;
                if (tt >= 0) { const unsigned w = *(const unsigned*)(PROJ + (size_t)(m - 3 + j) * NIN + col); a0 += cw[j * 1536 + col] * bflo(w); a1 += cw[j * 1536 + col + 1] * bfhi(w); } }
            r[s][0] = siluf(a0); r[s][1] = siluf(a1);
        }
        const float nq = wave_sum(r[0][0] * r[0][0] + r[0][1] * r[0][1]), nk = wave_sum(r[1][0] * r[1][0] + r[1][1] * r[1][1]);
        const float sq = rsqrtf(nq + 1e-6f) * 0.08838834764831845f, sk = rsqrtf(nk + 1e-6f);
        const size_t o = ((size_t)(b * 4 + h) * SEQ + t) * 128 + C.lane * 2;
        *(float2*)(GQ + o) = make_float2(r[0][0] * sq, r[0][1] * sq);
        *(float2*)(GK + o) = make_float2(r[1][0] * sk, r[1][1] * sk);
    }
}

__device__ __forceinline__ void phase_gdn_chunk(const Ctx& C, int l) {
    const float* cw = C.in[2] + (size_t)l * 4 * 1536;
    LAS float* Ks = (LAS float*)C.lds;
    LAS float* Ms = Ks + 64 * 129;
    LAS float* gcs = Ms + 64 * 65;
    LAS float* bts = gcs + 64;
    LAS float* Qs = bts + 64;
    LAS float* Us = Qs;
    const float* GQ = (const float*)(C.ws + WS_GQ); const float* GK = (const float*)(C.ws + WS_GK); const bf16* PROJ = (const bf16*)(C.ws + WS_PROJ);
    const float* beta = (const float*)(C.ws + WS_BETA); const float* g = (const float*)(C.ws + WS_G);
    float* GC = (float*)(C.ws + WS_GC); float* GU = (float*)(C.ws + WS_GU); float* GW = (float*)(C.ws + WS_GW); float* GQK = (float*)(C.ws + WS_GQK);
    const int tid = C.tid;
    for (int item = C.bid; item < 32 * 32; item += C.G) {
        const int bh = item >> 5, n = item & 31, b = bh >> 2, h = bh & 3;
        const size_t base = ((size_t)bh * SEQ + n * 64) * 128;
        for (int i = tid; i < 64 * 128; i += NTHREADS) { const int c = i >> 7, d = i & 127; Ks[c * 129 + d] = GK[base + i]; Qs[c * 129 + d] = GQ[base + i]; }
        if (tid < 64) { const size_t mi = ((size_t)b * SEQ + n * 64 + tid) * 4 + h; bts[tid] = beta[mi]; gcs[tid] = g[mi]; }
        __syncthreads();
        if (tid == 0) { float s = 0.f; for (int c = 0; c < 64; ++c) { s += gcs[c]; gcs[c] = s; } }
        __syncthreads();
        {
            const int c = tid >> 3, sg = tid & 7;
            float akk[8], aqk[8];
#pragma unroll
            for (int i = 0; i < 8; ++i) { akk[i] = 0.f; aqk[i] = 0.f; }
            for (int d = 0; d < 128; ++d) { const float kc = Ks[c * 129 + d], qc = Qs[c * 129 + d];
#pragma unroll
                for (int i = 0; i < 8; ++i) { const float ks = Ks[(sg + 8 * i) * 129 + d]; akk[i] += kc * ks; aqk[i] += qc * ks; } }
            const float gcc = gcs[c], bc = bts[c];
#pragma unroll
            for (int i = 0; i < 8; ++i) { const int s = sg + 8 * i; const float e = (c >= s) ? __expf(gcc - gcs[s]) : 0.f;
                Ms[c * 65 + s] = (c > s) ? bc * akk[i] * e : 0.f;
                GQK[((size_t)item * 64 + c) * 64 + s] = (c >= s) ? aqk[i] * e : 0.f; }
            if (tid < 64) GC[(size_t)bh * SEQ + n * 64 + tid] = gcs[tid];
        }
        __syncthreads();
        for (int i = tid; i < 64 * 128; i += NTHREADS) { const int c = i >> 7, d = i & 127; const float bc = bts[c];
            const int t = n * 64 + c, col = GV0 + h * 128 + d; const size_t mrow = (size_t)b * SEQ + t; float av = 0.f;
#pragma unroll
            for (int j = 0; j < 4; ++j) { if (t - 3 + j >= 0) av += cw[j * 1536 + col] * bf2f(PROJ[(mrow - 3 + j) * NIN + col]); }
            Us[c * 256 + d] = siluf(av) * bc; Us[c * 256 + 128 + d] = Ks[c * 129 + d] * bc * __expf(gcs[c]); }
        __syncthreads();
        if (tid < 256) {
            for (int c = 1; c < 64; ++c) { float acc = Us[c * 256 + tid];
                for (int s = 0; s < c; ++s) acc -= Ms[c * 65 + s] * Us[s * 256 + tid];
                Us[c * 256 + tid] = acc; }
        }
        __syncthreads();
        for (int i = tid; i < 64 * 128; i += NTHREADS) { const int c = i >> 7, d = i & 127; GU[(size_t)item * 8192 + i] = Us[c * 256 + d]; GW[(size_t)item * 8192 + i] = Us[c * 256 + 128 + d]; }
        __syncthreads();
    }
}

__device__ __forceinline__ void phase_gdn_scan(const Ctx& C) {
    LAS float* Wl = (LAS float*)C.lds;
    LAS float* Ql = Wl + 64 * 129;
    LAS float* Kl = Ql + 64 * 129;
    LAS float* QKl = Kl + 64 * 129;
    LAS float* Ss = QKl + 64 * 65;
    LAS float* Vn = Ss + 128 * 16;
    LAS float* gcl = Vn + 64 * 17;
    const float* GQ = (const float*)(C.ws + WS_GQ); const float* GK = (const float*)(C.ws + WS_GK);
    const float* GC = (const float*)(C.ws + WS_GC); const float* GU = (const float*)(C.ws + WS_GU); const float* GW = (const float*)(C.ws + WS_GW); const float* GQK = (const float*)(C.ws + WS_GQK);
    float* GO = (float*)(C.ws + WS_GO);
    const int tid = C.tid;
    for (int item = C.bid; item < 32 * 8; item += C.G) {
        const int bh = item >> 3, e0 = (item & 7) * 16;
        for (int i = tid; i < 128 * 16; i += NTHREADS) Ss[i] = 0.f;
        for (int n = 0; n < 32; ++n) {
            const size_t ch = (size_t)bh * 32 + n; const size_t base = ((size_t)bh * SEQ + n * 64) * 128;
            if (tid < 64) gcl[tid] = GC[(size_t)bh * SEQ + n * 64 + tid];
            __syncthreads();
            const float gl = gcl[63];
            for (int i = tid; i < 64 * 128; i += NTHREADS) { const int c = i >> 7, d = i & 127; const float gc = gcl[c];
                Wl[c * 129 + d] = GW[ch * 8192 + i]; Ql[c * 129 + d] = GQ[base + i] * __expf(gc); Kl[c * 129 + d] = GK[base + i] * __expf(gl - gc); }
            for (int i = tid; i < 64 * 64; i += NTHREADS) { const int c = i >> 6, s = i & 63; QKl[c * 65 + s] = GQK[ch * 4096 + i]; }
            __syncthreads();
            const int c = tid >> 3, e2 = (tid & 7) * 2;
            {
                float a0 = GU[ch * 8192 + c * 128 + e0 + e2], a1 = GU[ch * 8192 + c * 128 + e0 + e2 + 1];
                for (int d = 0; d < 128; ++d) { const float w = Wl[c * 129 + d]; a0 -= w * Ss[d * 16 + e2]; a1 -= w * Ss[d * 16 + e2 + 1]; }
                Vn[c * 17 + e2] = a0; Vn[c * 17 + e2 + 1] = a1;
            }
            __syncthreads();
            float o0 = 0.f, o1 = 0.f;
            for (int d = 0; d < 128; ++d) { const float q = Ql[c * 129 + d]; o0 += q * Ss[d * 16 + e2]; o1 += q * Ss[d * 16 + e2 + 1]; }
            for (int s = 0; s < 64; ++s) { const float k = QKl[c * 65 + s]; o0 += k * Vn[s * 17 + e2]; o1 += k * Vn[s * 17 + e2 + 1]; }
            *(float2*)(GO + base + (size_t)c * 128 + e0 + e2) = make_float2(o0, o1);
            const int d2 = tid >> 2, e4 = (tid & 3) * 4; const float eg = __expf(gl);
            float s0 = Ss[d2 * 16 + e4] * eg, s1 = Ss[d2 * 16 + e4 + 1] * eg, s2 = Ss[d2 * 16 + e4 + 2] * eg, s3 = Ss[d2 * 16 + e4 + 3] * eg;
            for (int c2 = 0; c2 < 64; ++c2) { const float k = Kl[c2 * 129 + d2]; s0 += k * Vn[c2 * 17 + e4]; s1 += k * Vn[c2 * 17 + e4 + 1]; s2 += k * Vn[c2 * 17 + e4 + 2]; s3 += k * Vn[c2 * 17 + e4 + 3]; }
            __syncthreads();
            Ss[d2 * 16 + e4] = s0; Ss[d2 * 16 + e4 + 1] = s1; Ss[d2 * 16 + e4 + 2] = s2; Ss[d2 * 16 + e4 + 3] = s3;
        }
        __syncthreads();
    }
}

__device__ __forceinline__ void phase_gdn_out(const Ctx& C, int l) {
    const bf16* PROJ = (const bf16*)(C.ws + WS_PROJ); const float* GO = (const float*)(C.ws + WS_GO); bf16* MIX = (bf16*)(C.ws + WS_MIX);
    const float* nw = C.in[5] + l * 128;
    for (int it = C.gw; it < M * 4; it += C.ngw) {
        const int m = it >> 2, h = it & 3, t = m & (SEQ - 1), b = m >> 11;
        const float2 o = *(const float2*)(GO + ((size_t)(b * 4 + h) * SEQ + t) * 128 + C.lane * 2);
        const float ms = wave_sum(o.x * o.x + o.y * o.y) * (1.f / 128.f); const float r = rsqrtf(ms + LN_EPS);
        const unsigned zw = *(const unsigned*)(PROJ + (size_t)m * NIN + GZ0 + h * 128 + C.lane * 2);
        const float y0 = o.x * r * nw[C.lane * 2] * siluf(bflo(zw)), y1 = o.y * r * nw[C.lane * 2 + 1] * siluf(bfhi(zw));
        *(unsigned*)(MIX + (size_t)m * DM + h * 128 + C.lane * 2) = pk2(y0, y1);
    }
}

__device__ __forceinline__ void phase_dsw(const Ctx& C) {
    const bf16* PROJ = (const bf16*)(C.ws + WS_PROJ); bf16* MIX = (bf16*)(C.ws + WS_MIX);
    for (int item = C.gw; item < 32 * 64; item += C.ngw) {
        const int bh = item >> 6, gq = item & 63, b = bh >> 2, h = bh & 3;
        const int t = gq * 32 + (C.lane & 31), half = C.lane >> 5, m = b * SEQ + t;
        float q[64];
        { const v4u* qp = (const v4u*)(PROJ + (size_t)m * NIN + BQ0 + h * 64);
#pragma unroll
          for (int i = 0; i < 8; ++i) { const v4u w = qp[i]; q[8 * i] = bflo(w.x); q[8 * i + 1] = bfhi(w.x); q[8 * i + 2] = bflo(w.y); q[8 * i + 3] = bfhi(w.y); q[8 * i + 4] = bflo(w.z); q[8 * i + 5] = bfhi(w.z); q[8 * i + 6] = bflo(w.w); q[8 * i + 7] = bfhi(w.w); } }
        float o[32];
#pragma unroll
        for (int i = 0; i < 32; ++i) o[i] = 0.f;
        float mrun = -INFINITY, lsum = 0.f;
        for (int p = 0; p < 3; ++p) {
            const int dil = 1 << (2 * p);
            for (int j = 0; j <= 128; ++j) {
                const int tk = t - j * dil;
                if (tk >= 0) {
                    const bf16* row = PROJ + (size_t)(m - j * dil) * NIN;
                    const v4u* kp = (const v4u*)(row + BK0 + h * 64);
                    float s = 0.f;
#pragma unroll
                    for (int i = 0; i < 8; ++i) { const v4u w = kp[i]; s += q[8 * i] * bflo(w.x) + q[8 * i + 1] * bfhi(w.x) + q[8 * i + 2] * bflo(w.y) + q[8 * i + 3] * bfhi(w.y) + q[8 * i + 4] * bflo(w.z) + q[8 * i + 5] * bfhi(w.z) + q[8 * i + 6] * bflo(w.w) + q[8 * i + 7] * bfhi(w.w); }
                    s *= 0.125f;
                    const float mn = fmaxf(mrun, s), a = __expf(mrun - mn), pe = __expf(s - mn);
                    lsum = lsum * a + pe; mrun = mn;
                    const v4u* vp = (const v4u*)(row + BV0 + h * 64 + half * 32);
#pragma unroll
                    for (int i = 0; i < 4; ++i) { const v4u w = vp[i];
                        o[8 * i] = o[8 * i] * a + pe * bflo(w.x); o[8 * i + 1] = o[8 * i + 1] * a + pe * bfhi(w.x); o[8 * i + 2] = o[8 * i + 2] * a + pe * bflo(w.y); o[8 * i + 3] = o[8 * i + 3] * a + pe * bfhi(w.y);
                        o[8 * i + 4] = o[8 * i + 4] * a + pe * bflo(w.z); o[8 * i + 5] = o[8 * i + 5] * a + pe * bfhi(w.z); o[8 * i + 6] = o[8 * i + 6] * a + pe * bflo(w.w); o[8 * i + 7] = o[8 * i + 7] * a + pe * bfhi(w.w); }
                }
            }
        }
        const float inv = 1.f / lsum;
        v4u* op = (v4u*)(MIX + (size_t)m * DM + 512 + h * 64 + half * 32);
#pragma unroll
        for (int i = 0; i < 4; ++i) { v4u w; w.x = pk2(o[8 * i] * inv, o[8 * i + 1] * inv); w.y = pk2(o[8 * i + 2] * inv, o[8 * i + 3] * inv); w.z = pk2(o[8 * i + 4] * inv, o[8 * i + 5] * inv); w.w = pk2(o[8 * i + 6] * inv, o[8 * i + 7] * inv); op[i] = w; }
    }
}

__device__ __forceinline__ void phase_diff(const Ctx& C, int l) {
    const bf16* PROJ = (const bf16*)(C.ws + WS_PROJ); bf16* MIX = (bf16*)(C.ws + WS_MIX);
    const float* lv = C.in[6] + l * 128; const float* nw = C.in[7] + l * 64;
    const float lam_init = 0.8f - 0.6f * expf(-0.3f * (float)l);
    float d01 = 0.f, d23 = 0.f;
    for (int i = 0; i < 32; ++i) { d01 += lv[i] * lv[32 + i]; d23 += lv[64 + i] * lv[96 + i]; }
    const float lam = expf(d01) - expf(d23) + lam_init;
    for (int it = C.bid; it < 256; it += C.G) {
        const int pairIdx = it * 4 + (C.wave & 3), bh = pairIdx >> 5, gg = pairIdx & 31, gq = (C.wave < 4) ? gg : 63 - gg;
        const int b = bh >> 2, h = bh & 3, t = gq * 32 + (C.lane & 31), half = C.lane >> 5, m = b * SEQ + t;
        float q1[32], q2[32];
        { const v4u* qp = (const v4u*)(PROJ + (size_t)m * NIN + CQ0 + h * 64);
#pragma unroll
          for (int i = 0; i < 4; ++i) { const v4u w = qp[i]; q1[8 * i] = bflo(w.x); q1[8 * i + 1] = bfhi(w.x); q1[8 * i + 2] = bflo(w.y); q1[8 * i + 3] = bfhi(w.y); q1[8 * i + 4] = bflo(w.z); q1[8 * i + 5] = bfhi(w.z); q1[8 * i + 6] = bflo(w.w); q1[8 * i + 7] = bfhi(w.w); }
#pragma unroll
          for (int i = 0; i < 4; ++i) { const v4u w = qp[4 + i]; q2[8 * i] = bflo(w.x); q2[8 * i + 1] = bfhi(w.x); q2[8 * i + 2] = bflo(w.y); q2[8 * i + 3] = bfhi(w.y); q2[8 * i + 4] = bflo(w.z); q2[8 * i + 5] = bfhi(w.z); q2[8 * i + 6] = bflo(w.w); q2[8 * i + 7] = bfhi(w.w); } }
        float o1[32], o2[32];
#pragma unroll
        for (int i = 0; i < 32; ++i) { o1[i] = 0.f; o2[i] = 0.f; }
        float m1 = -INFINITY, l1 = 0.f, m2 = -INFINITY, l2 = 0.f;
        const int nkeys = gq * 32 + 32;
        for (int j = 0; j < nkeys; ++j) {
            const bf16* row = PROJ + (size_t)(b * SEQ + j) * NIN;
            const v4u* kp = (const v4u*)(row + CK0 + h * 64);
            float s1 = 0.f, s2 = 0.f;
#pragma unroll
            for (int i = 0; i < 4; ++i) { const v4u w = kp[i]; s1 += q1[8 * i] * bflo(w.x) + q1[8 * i + 1] * bfhi(w.x) + q1[8 * i + 2] * bflo(w.y) + q1[8 * i + 3] * bfhi(w.y) + q1[8 * i + 4] * bflo(w.z) + q1[8 * i + 5] * bfhi(w.z) + q1[8 * i + 6] * bflo(w.w) + q1[8 * i + 7] * bfhi(w.w); }
#pragma unroll
            for (int i = 0; i < 4; ++i) { const v4u w = kp[4 + i]; s2 += q2[8 * i] * bflo(w.x) + q2[8 * i + 1] * bfhi(w.x) + q2[8 * i + 2] * bflo(w.y) + q2[8 * i + 3] * bfhi(w.y) + q2[8 * i + 4] * bflo(w.z) + q2[8 * i + 5] * bfhi(w.z) + q2[8 * i + 6] * bflo(w.w) + q2[8 * i + 7] * bfhi(w.w); }
            if (j <= t) {
                s1 *= 0.17677669529663687f; s2 *= 0.17677669529663687f;
                const float mn1 = fmaxf(m1, s1), a1 = __expf(m1 - mn1), p1 = __expf(s1 - mn1); l1 = l1 * a1 + p1; m1 = mn1;
                const float mn2 = fmaxf(m2, s2), a2 = __expf(m2 - mn2), p2 = __expf(s2 - mn2); l2 = l2 * a2 + p2; m2 = mn2;
                const v4u* vp = (const v4u*)(row + CV0 + h * 64 + half * 32);
#pragma unroll
                for (int i = 0; i < 4; ++i) { const v4u w = vp[i]; float vv[8] = {bflo(w.x), bfhi(w.x), bflo(w.y), bfhi(w.y), bflo(w.z), bfhi(w.z), bflo(w.w), bfhi(w.w)};
#pragma unroll
                    for (int e = 0; e < 8; ++e) { o1[8 * i + e] = o1[8 * i + e] * a1 + p1 * vv[e]; o2[8 * i + e] = o2[8 * i + e] * a2 + p2 * vv[e]; } }
            }
        }
        const float i1 = 1.f / l1, i2 = lam / l2; float ss = 0.f;
#pragma unroll
        for (int i = 0; i < 32; ++i) { o1[i] = o1[i] * i1 - o2[i] * i2; ss += o1[i] * o1[i]; }
        ss += __shfl_xor(ss, 32);
        const float r = rsqrtf(ss * (1.f / 64.f) + LN_EPS) * (1.f - lam_init);
        v4u* op = (v4u*)(MIX + (size_t)m * DM + 768 + h * 64 + half * 32); const float* nwp = nw + half * 32;
#pragma unroll
        for (int i = 0; i < 4; ++i) { v4u w; w.x = pk2(o1[8 * i] * r * nwp[8 * i], o1[8 * i + 1] * r * nwp[8 * i + 1]); w.y = pk2(o1[8 * i + 2] * r * nwp[8 * i + 2], o1[8 * i + 3] * r * nwp[8 * i + 3]);
            w.z = pk2(o1[8 * i + 4] * r * nwp[8 * i + 4], o1[8 * i + 5] * r * nwp[8 * i + 5]); w.w = pk2(o1[8 * i + 6] * r * nwp[8 * i + 6], o1[8 * i + 7] * r * nwp[8 * i + 7]); op[i] = w; }
    }
}

__device__ __forceinline__ void phase_glu(const Ctx& C, int l) {
    const bf16* U = (const bf16*)(C.ws + WS_U); bf16* H = (bf16*)(C.ws + WS_H); const float* cw = C.in[12] + (size_t)l * 3 * NUP_SRC;
    const int gt = C.bid * NTHREADS + C.tid, ngt = C.G * NTHREADS;
    constexpr int GPR = KDN / 8;
    for (int i = gt; i < M * GPR; i += ngt) {
        const int m = i / GPR, gcol = i - m * GPR, j0 = gcol * 8, t = m & (SEQ - 1);
        v4u outw = (v4u){0u, 0u, 0u, 0u};
        if (j0 < DFF) {
            float ag[8], av[8];
#pragma unroll
            for (int e = 0; e < 8; ++e) { ag[e] = 0.f; av[e] = 0.f; }
#pragma unroll
            for (int k = 0; k < 3; ++k) { const int tt = t - 2 + k;
                if (tt >= 0) { const bf16* row = U + (size_t)(m - 2 + k) * NUP; const v4u wg = *(const v4u*)(row + j0), wv = *(const v4u*)(row + DFF + j0);
                    const float* cg = cw + k * NUP_SRC + j0; const float* cv = cg + DFF;
                    const float g8[8] = {bflo(wg.x), bfhi(wg.x), bflo(wg.y), bfhi(wg.y), bflo(wg.z), bfhi(wg.z), bflo(wg.w), bfhi(wg.w)};
                    const float v8[8] = {bflo(wv.x), bfhi(wv.x), bflo(wv.y), bfhi(wv.y), bflo(wv.z), bfhi(wv.z), bflo(wv.w), bfhi(wv.w)};
#pragma unroll
                    for (int e = 0; e < 8; ++e) { ag[e] += cg[e] * g8[e]; av[e] += cv[e] * v8[e]; } } }
            outw.x = pk2(siluf(ag[0]) * av[0], siluf(ag[1]) * av[1]); outw.y = pk2(siluf(ag[2]) * av[2], siluf(ag[3]) * av[3]);
            outw.z = pk2(siluf(ag[4]) * av[4], siluf(ag[5]) * av[5]); outw.w = pk2(siluf(ag[6]) * av[6], siluf(ag[7]) * av[7]);
        }
        *(v4u*)(H + (size_t)m * KDN + j0) = outw;
    }
}


typedef short bf16x8v __attribute__((ext_vector_type(8)));
typedef float f32x16 __attribute__((ext_vector_type(16)));
typedef short s16x4 __attribute__((ext_vector_type(4)));
typedef float f32x2_t __attribute__((ext_vector_type(2)));
typedef __bf16 bf16x2_t __attribute__((ext_vector_type(2)));
__device__ __forceinline__ unsigned cvtpk(float lo, float hi) { f32x2_t v = {lo, hi}; bf16x2_t b = __builtin_convertvector(v, bf16x2_t); return __builtin_bit_cast(unsigned, b); }
__device__ __forceinline__ int crow(int r, int hi) { return (r & 3) + 8 * (r >> 2) + 4 * hi; }
__device__ __forceinline__ s16x4 ldtr(LAS const unsigned char* p) { return __builtin_bit_cast(s16x4, __builtin_amdgcn_ds_read_tr16_b64_v4i16((LAS s16x4*)p)); }
__device__ __forceinline__ f32x16 zero16() { f32x16 z; for (int i = 0; i < 16; ++i) z[i] = 0.f; return z; }

__device__ __forceinline__ void sm_update(f32x16& s, float& m, float& l, f32x16& o0, f32x16& o1, float c) {
    float t0 = fmaxf(fmaxf(s[0], s[1]), fmaxf(s[2], s[3])), t1 = fmaxf(fmaxf(s[4], s[5]), fmaxf(s[6], s[7]));
    float t2 = fmaxf(fmaxf(s[8], s[9]), fmaxf(s[10], s[11])), t3 = fmaxf(fmaxf(s[12], s[13]), fmaxf(s[14], s[15]));
    float tmax = fmaxf(fmaxf(t0, t1), fmaxf(t2, t3));
    tmax = fmaxf(tmax, __shfl_xor(tmax, 32));
    const float mn = fmaxf(m, tmax);
    const float ms = (mn == -INFINITY) ? 0.f : mn;
    const float alpha = __builtin_amdgcn_exp2f((m - ms) * c);
    const float msc = ms * c;
    float rs = 0.f;
#pragma unroll
    for (int r = 0; r < 16; ++r) { s[r] = __builtin_amdgcn_exp2f(__builtin_fmaf(s[r], c, -msc)); rs += s[r]; }
    rs += __shfl_xor(rs, 32);
    l = l * alpha + rs; m = mn;
    o0 = o0 * alpha; o1 = o1 * alpha;
}
__device__ __forceinline__ bf16x8v pfrag(const f32x16& p, int s) {
    v4u w; w.x = cvtpk(p[8 * s], p[8 * s + 1]); w.y = cvtpk(p[8 * s + 2], p[8 * s + 3]); w.z = cvtpk(p[8 * s + 4], p[8 * s + 5]); w.w = cvtpk(p[8 * s + 6], p[8 * s + 7]);
    return __builtin_bit_cast(bf16x8v, w);
}
__device__ __forceinline__ bf16x8v vfrag(LAS const unsigned char* vl, int db, int s) {
    const s16x4 lo = ldtr(vl + db * 2048 + s * 1024), hi = ldtr(vl + db * 2048 + s * 1024 + 512);
    return (bf16x8v){lo[0], lo[1], lo[2], lo[3], hi[0], hi[1], hi[2], hi[3]};
}

__device__ __forceinline__ void phase_diff_mfma(const Ctx& C, int l) {
    const bf16* PROJ = (const bf16*)(C.ws + WS_PROJ); bf16* MIX = (bf16*)(C.ws + WS_MIX);
    const float* lv = C.in[6] + l * 128; const float* nw = C.in[7] + l * 64;
    const float lam_init = 0.8f - 0.6f * expf(-0.3f * (float)l);
    float d01 = 0.f, d23 = 0.f;
    for (int i = 0; i < 32; ++i) { d01 += lv[i] * lv[32 + i]; d23 += lv[64 + i] * lv[96 + i]; }
    const float lam = expf(d01) - expf(d23) + lam_init;
    const int lane = C.lane, q32 = lane & 31, hi = lane >> 5;
    LAS unsigned char* vbuf = C.lds + C.wave * 8192;
    LAS unsigned char* vst = vbuf + (lane & 1) * 2048 + (lane >> 1) * 64;
    const int trofs = (4 * hi + ((lane & 15) >> 2)) * 64 + (((lane >> 4) & 1) * 16 + (lane & 3) * 4) * 2;
    const float c = 0.17677669529663687f * 1.4426950408889634f;
    for (int it = C.bid; it < 256; it += C.G) {
        const int pairIdx = it * 4 + (C.wave & 3), bh = pairIdx >> 5, gg = pairIdx & 31, qt = (C.wave < 4) ? gg : 63 - gg;
        const int b = bh >> 2, h = bh & 3;
        const bf16* qrow = PROJ + (size_t)(b * SEQ + qt * 32 + q32) * NIN + CQ0 + h * 64 + 8 * hi;
        bf16x8v bq[2][2];
#pragma unroll
        for (int mm = 0; mm < 2; ++mm)
#pragma unroll
            for (int s = 0; s < 2; ++s) bq[mm][s] = *(const bf16x8v*)(qrow + mm * 32 + 16 * s);
        f32x16 o[2][2]; o[0][0] = zero16(); o[0][1] = zero16(); o[1][0] = zero16(); o[1][1] = zero16();
        float m1 = -INFINITY, m2 = -INFINITY, l1 = 0.f, l2 = 0.f;
        const bf16* kbase = PROJ + (size_t)(b * SEQ + q32) * NIN + CK0 + h * 64 + 8 * hi;
        const bf16* vbase = PROJ + (size_t)(b * SEQ + (lane >> 1)) * NIN + CV0 + h * 64 + 32 * (lane & 1);
        bf16x8v ak[2][2]; v4u vr[4];
#pragma unroll
        for (int mm = 0; mm < 2; ++mm)
#pragma unroll
            for (int s = 0; s < 2; ++s) ak[mm][s] = *(const bf16x8v*)(kbase + mm * 32 + 16 * s);
#pragma unroll
        for (int i = 0; i < 4; ++i) vr[i] = *(const v4u*)(vbase + 8 * i);
#pragma unroll
        for (int i = 0; i < 4; ++i) *(LAS v4u*)(vst + 16 * i) = vr[i];
        for (int kt = 0; kt <= qt; ++kt) {
            bf16x8v akn[2][2];
            const bool more = kt < qt;
            if (more) {
                const size_t ro = (size_t)(kt + 1) * 32 * NIN;
#pragma unroll
                for (int mm = 0; mm < 2; ++mm)
#pragma unroll
                    for (int s = 0; s < 2; ++s) akn[mm][s] = *(const bf16x8v*)(kbase + ro + mm * 32 + 16 * s);
#pragma unroll
                for (int i = 0; i < 4; ++i) vr[i] = *(const v4u*)(vbase + ro + 8 * i);
            }
            f32x16 s1 = zero16(), s2 = zero16();
            s1 = __builtin_amdgcn_mfma_f32_32x32x16_bf16(ak[0][0], bq[0][0], s1, 0, 0, 0); s2 = __builtin_amdgcn_mfma_f32_32x32x16_bf16(ak[1][0], bq[1][0], s2, 0, 0, 0);
            s1 = __builtin_amdgcn_mfma_f32_32x32x16_bf16(ak[0][1], bq[0][1], s1, 0, 0, 0); s2 = __builtin_amdgcn_mfma_f32_32x32x16_bf16(ak[1][1], bq[1][1], s2, 0, 0, 0);
            if (kt == qt) {
#pragma unroll
                for (int r = 0; r < 16; ++r) { if (crow(r, hi) > q32) { s1[r] = -INFINITY; s2[r] = -INFINITY; } }
            }
            sm_update(s1, m1, l1, o[0][0], o[0][1], c);
            sm_update(s2, m2, l2, o[1][0], o[1][1], c);
            LAS const unsigned char* vl = vbuf + (kt & 1) * 4096 + trofs;
#pragma unroll
            for (int s = 0; s < 2; ++s) {
                const bf16x8v p1 = pfrag(s1, s), p2 = pfrag(s2, s);
#pragma unroll
                for (int db = 0; db < 2; ++db) { const bf16x8v vf = vfrag(vl, db, s);
                    o[0][db] = __builtin_amdgcn_mfma_f32_32x32x16_bf16(vf, p1, o[0][db], 0, 0, 0);
                    o[1][db] = __builtin_amdgcn_mfma_f32_32x32x16_bf16(vf, p2, o[1][db], 0, 0, 0); }
            }
            if (more) {
#pragma unroll
                for (int i = 0; i < 4; ++i) *(LAS v4u*)(vst + ((kt + 1) & 1) * 4096 + 16 * i) = vr[i];
#pragma unroll
                for (int mm = 0; mm < 2; ++mm)
#pragma unroll
                    for (int s = 0; s < 2; ++s) ak[mm][s] = akn[mm][s];
            }
        }
        const float i1 = 1.f / l1, i2 = lam / l2; float ss = 0.f;
#pragma unroll
        for (int db = 0; db < 2; ++db)
#pragma unroll
            for (int r = 0; r < 16; ++r) { const float v = o[0][db][r] * i1 - o[1][db][r] * i2; o[0][db][r] = v; ss += v * v; }
        ss += __shfl_xor(ss, 32);
        const float rn = rsqrtf(ss * (1.f / 64.f) + LN_EPS) * (1.f - lam_init);
        bf16* orow = MIX + (size_t)(b * SEQ + qt * 32 + q32) * DM + 768 + h * 64;
#pragma unroll
        for (int db = 0; db < 2; ++db)
#pragma unroll
            for (int g4 = 0; g4 < 4; ++g4) { const int d = 32 * db + 8 * g4 + 4 * hi; const f32x4 w4 = *(const f32x4*)(nw + d);
                v2u w; w.x = cvtpk(o[0][db][4 * g4] * rn * w4.x, o[0][db][4 * g4 + 1] * rn * w4.y); w.y = cvtpk(o[0][db][4 * g4 + 2] * rn * w4.z, o[0][db][4 * g4 + 3] * rn * w4.w);
                *(v2u*)(orow + d) = w; }
    }
}

__device__ __forceinline__ void phase_dsw_mfma(const Ctx& C) {
    const bf16* PROJ = (const bf16*)(C.ws + WS_PROJ); bf16* MIX = (bf16*)(C.ws + WS_MIX);
    const int lane = C.lane, q32 = lane & 31, hi = lane >> 5;
    LAS unsigned char* vbuf = C.lds + C.wave * 8192;
    LAS unsigned char* vst = vbuf + (lane & 1) * 2048 + (lane >> 1) * 64;
    const int trofs = (4 * hi + ((lane & 15) >> 2)) * 64 + (((lane >> 4) & 1) * 16 + (lane & 3) * 4) * 2;
    const float c = 0.125f * 1.4426950408889634f;
    for (int item = C.gw; item < 32 * 64; item += C.ngw) {
        const int bh = item >> 6, cr = (item >> 2) & 15, j = item & 3, b = bh >> 2, h = bh & 3;
        const int tq = cr + 512 * j + 16 * q32;
        const bf16* qrow = PROJ + (size_t)(b * SEQ + tq) * NIN + BQ0 + h * 64 + 8 * hi;
        bf16x8v bq[4];
#pragma unroll
        for (int s = 0; s < 4; ++s) bq[s] = *(const bf16x8v*)(qrow + 16 * s);
        f32x16 o0 = zero16(), o1 = zero16(); float m = -INFINITY, lsum = 0.f;
        const bf16* kb0 = PROJ + (size_t)(b * SEQ) * NIN + BK0 + h * 64 + 8 * hi;
        const bf16* vb0 = PROJ + (size_t)(b * SEQ) * NIN + BV0 + h * 64 + 32 * (lane & 1);
        int par = 0;
        for (int p = 0; p < 3; ++p) {
            const int sh = 2 * p, dil = 1 << sh, res = cr & (dil - 1);
            const int posq = (tq - res) >> sh;
            const int pos0 = (cr - res + 512 * j) >> sh, pos31 = pos0 + (496 >> sh);
            const int lo = pos0 - 128; const int kt0 = lo > 0 ? (lo >> 5) : 0, kt1 = pos31 >> 5;
            bf16x8v ak[4]; v4u vr[4];
            { const size_t kr = (size_t)(((kt0 * 32 + q32) << sh) + res) * NIN, vrw = (size_t)(((kt0 * 32 + (lane >> 1)) << sh) + res) * NIN;
#pragma unroll
              for (int s = 0; s < 4; ++s) ak[s] = *(const bf16x8v*)(kb0 + kr + 16 * s);
#pragma unroll
              for (int i = 0; i < 4; ++i) vr[i] = *(const v4u*)(vb0 + vrw + 8 * i);
#pragma unroll
              for (int i = 0; i < 4; ++i) *(LAS v4u*)(vst + par * 4096 + 16 * i) = vr[i]; }
            for (int kt = kt0; kt <= kt1; ++kt) {
                bf16x8v akn[4];
                const bool more = kt < kt1;
                if (more) { const size_t kr = (size_t)((((kt + 1) * 32 + q32) << sh) + res) * NIN, vrw = (size_t)((((kt + 1) * 32 + (lane >> 1)) << sh) + res) * NIN;
#pragma unroll
                    for (int s = 0; s < 4; ++s) akn[s] = *(const bf16x8v*)(kb0 + kr + 16 * s);
#pragma unroll
                    for (int i = 0; i < 4; ++i) vr[i] = *(const v4u*)(vb0 + vrw + 8 * i); }
                f32x16 sc = zero16();
#pragma unroll
                for (int s = 0; s < 4; ++s) sc = __builtin_amdgcn_mfma_f32_32x32x16_bf16(ak[s], bq[s], sc, 0, 0, 0);
                const int dbase = posq - kt * 32;
#pragma unroll
                for (int r = 0; r < 16; ++r) { const int dist = dbase - crow(r, hi); if (dist < 0 || dist > 128) sc[r] = -INFINITY; }
                sm_update(sc, m, lsum, o0, o1, c);
                LAS const unsigned char* vl = vbuf + par * 4096 + trofs;
#pragma unroll
                for (int s = 0; s < 2; ++s) { const bf16x8v pf = pfrag(sc, s);
                    o0 = __builtin_amdgcn_mfma_f32_32x32x16_bf16(vfrag(vl, 0, s), pf, o0, 0, 0, 0);
                    o1 = __builtin_amdgcn_mfma_f32_32x32x16_bf16(vfrag(vl, 1, s), pf, o1, 0, 0, 0); }
                par ^= 1;
                if (more) {
#pragma unroll
                    for (int i = 0; i < 4; ++i) *(LAS v4u*)(vst + par * 4096 + 16 * i) = vr[i];
#pragma unroll
                    for (int s = 0; s < 4; ++s) ak[s] = akn[s];
                }
            }
        }
        const float inv = 1.f / lsum;
        bf16* orow = MIX + (size_t)(b * SEQ + tq) * DM + 512 + h * 64;
#pragma unroll
        for (int g4 = 0; g4 < 4; ++g4) { const int d = 8 * g4 + 4 * hi;
            v2u w; w.x = cvtpk(o0[4 * g4] * inv, o0[4 * g4 + 1] * inv); w.y = cvtpk(o0[4 * g4 + 2] * inv, o0[4 * g4 + 3] * inv); *(v2u*)(orow + d) = w;
            v2u x; x.x = cvtpk(o1[4 * g4] * inv, o1[4 * g4 + 1] * inv); x.y = cvtpk(o1[4 * g4 + 2] * inv, o1[4 * g4 + 3] * inv); *(v2u*)(orow + 32 + d) = x; }
    }
}

constexpr int KB_PITCH = 272;
constexpr int MS_PITCH = 68;
__device__ __forceinline__ void phase_gdn_chunk_mfma(const Ctx& C, int l) {
    LAS unsigned char* Kb = C.lds;
    LAS unsigned char* Qb = Kb + 64 * KB_PITCH;
    LAS float* Ms = (LAS float*)(Qb + 64 * KB_PITCH);
    LAS float* gcs = Ms + 64 * MS_PITCH;
    LAS float* bts = gcs + 64;
    LAS float* rown = bts + 64;
    LAS float* Rs = rown + 128;
    const bf16* PROJ = (const bf16*)(C.ws + WS_PROJ); const float* cw = C.in[2] + (size_t)l * 4 * 1536;
    const float* beta = (const float*)(C.ws + WS_BETA); const float* g = (const float*)(C.ws + WS_G);
    float* GU = (float*)(C.ws + WS_GU); bf16* NWg = (bf16*)(C.ws + WS_NW); bf16* QDg = (bf16*)(C.ws + WS_QD); bf16* KTg = (bf16*)(C.ws + WS_KT); bf16* QKg = (bf16*)(C.ws + WS_QKB); float* EGL = (float*)(C.ws + WS_EGL);
    const int tid = C.tid, lane = C.lane, wave = C.wave, q32 = lane & 31, hi = lane >> 5;
    for (int item = C.bid; item < 32 * 32; item += C.G) {
        const int bh = item >> 5, n = item & 31, b = bh >> 2, h = bh & 3;
        const int t0 = n * 64; const size_t m0 = (size_t)b * SEQ + t0;
        if (wave == 0) {
            float v = g[(m0 + lane) * 4 + h];
#pragma unroll
            for (int off = 1; off < 64; off <<= 1) { const float t = __shfl_up(v, off); if (lane >= off) v += t; }
            gcs[lane] = v; bts[lane] = beta[(m0 + lane) * 4 + h];
            if (lane == 63) EGL[item] = __expf(v);
        }
        if (tid >= 128 && tid < 256) rown[tid - 128] = 0.f;
        __syncthreads();
        {
            const int col = tid & 255, half = tid >> 8, tsel = col >> 7, d = col & 127, pc = tsel * 512 + h * 128 + d;
            const float w0 = cw[pc], w1 = cw[1536 + pc], w2 = cw[2 * 1536 + pc], w3 = cw[3 * 1536 + pc];
            const int c0 = half * 32; const bf16* pp = PROJ + (m0 + c0) * NIN + pc;
            float x3 = (t0 + c0 - 3 >= 0) ? bf2f(pp[-3 * NIN]) : 0.f, x2 = (t0 + c0 - 2 >= 0) ? bf2f(pp[-2 * NIN]) : 0.f, x1 = (t0 + c0 - 1 >= 0) ? bf2f(pp[-1 * NIN]) : 0.f;
#pragma unroll 4
            for (int c = 0; c < 32; ++c) { const float xn = bf2f(*pp); pp += NIN; const float y = siluf(w0 * x3 + w1 * x2 + w2 * x1 + w3 * xn); x3 = x2; x2 = x1; x1 = xn;
                Rs[(c0 + c) * 256 + col] = y; __hip_atomic_fetch_add(&rown[(c0 + c) * 2 + tsel], y * y, __ATOMIC_RELAXED, __HIP_MEMORY_SCOPE_WORKGROUP); }
            __syncthreads();
            LAS unsigned short* dst = (LAS unsigned short*)((tsel ? Kb : Qb) + c0 * KB_PITCH + d * 2);
            const float sc = tsel ? 1.f : 0.08838834764831845f;
#pragma unroll 4
            for (int c = 0; c < 32; ++c) { const float y = Rs[(c0 + c) * 256 + col]; const float rn = rsqrtf(rown[(c0 + c) * 2 + tsel] + 1e-6f) * sc; const unsigned short hb = (unsigned short)f2bf(y * rn); const float vb = bf2f(hb);
                *dst = hb; dst += KB_PITCH / 2;
                if (tsel) Rs[(c0 + c) * 256 + col] = vb * bts[c0 + c] * __expf(gcs[c0 + c]); }
        }
        __syncthreads();
        {
            const int d = tid & 127, qr = tid >> 7, pc = 1024 + h * 128 + d;
            const float w0 = cw[pc], w1 = cw[1536 + pc], w2 = cw[2 * 1536 + pc], w3 = cw[3 * 1536 + pc];
            const int c0 = qr * 16; const bf16* pp = PROJ + (m0 + c0) * NIN + pc;
            float x3 = (t0 + c0 - 3 >= 0) ? bf2f(pp[-3 * NIN]) : 0.f, x2 = (t0 + c0 - 2 >= 0) ? bf2f(pp[-2 * NIN]) : 0.f, x1 = (t0 + c0 - 1 >= 0) ? bf2f(pp[-1 * NIN]) : 0.f;
#pragma unroll 4
            for (int c = 0; c < 16; ++c) { const float xn = bf2f(*pp); pp += NIN; Rs[(c0 + c) * 256 + d] = siluf(w0 * x3 + w1 * x2 + w2 * x1 + w3 * xn) * bts[c0 + c]; x3 = x2; x2 = x1; x1 = xn; }
        }
        __syncthreads();
        {
            const int prod = wave >> 2, ti = (wave >> 1) & 1, tj = wave & 1;
            LAS const unsigned char* ap = (prod ? Qb : Kb) + (32 * ti + q32) * KB_PITCH + 16 * hi;
            LAS const unsigned char* bp = Kb + (32 * tj + q32) * KB_PITCH + 16 * hi;
            f32x16 acc = zero16();
#pragma unroll
            for (int ks = 0; ks < 8; ++ks) acc = __builtin_amdgcn_mfma_f32_32x32x16_bf16(*(LAS const bf16x8v*)(ap + 32 * ks), *(LAS const bf16x8v*)(bp + 32 * ks), acc, 0, 0, 0);
            const int s = 32 * tj + q32; const float gs = gcs[s];
#pragma unroll
            for (int r = 0; r < 16; ++r) { const int c = 32 * ti + crow(r, hi); const float e = (c >= s) ? __expf(gcs[c] - gs) : 0.f;
                if (prod == 0) Ms[c * MS_PITCH + s] = (c > s) ? bts[c] * acc[r] * e : 0.f;
                else QKg[((size_t)item * 64 + c) * 64 + s] = (unsigned short)f2bf((c >= s) ? acc[r] * e : 0.f); }
        }
        __syncthreads();
        if (tid < 256) {
            float u[64];
#pragma unroll
            for (int c = 0; c < 64; ++c) u[c] = 0.f;
#pragma unroll
            for (int c = 0; c < 64; ++c) { float acc = Rs[c * 256 + tid];
#pragma unroll
                for (int s4 = 0; s4 < (c + 3) / 4; ++s4) { const f32x4 mm = *(LAS const f32x4*)(Ms + c * MS_PITCH + 4 * s4);
                    acc -= mm.x * u[4 * s4]; acc -= mm.y * u[4 * s4 + 1]; acc -= mm.z * u[4 * s4 + 2]; acc -= mm.w * u[4 * s4 + 3]; }
                u[c] = acc; Rs[c * 256 + tid] = acc; }
        }
        else {
            const int t2 = tid - 256; const float gl = gcs[63];
#pragma unroll
            for (int k = 0; k < 4; ++k) { const int i = t2 + 256 * k, c = i >> 4, ch = i & 15; const v4u w = *(LAS const v4u*)(Qb + c * KB_PITCH + ch * 16); const float e = __expf(gcs[c]);
                v4u o; o.x = pk2(bflo(w.x) * e, bfhi(w.x) * e); o.y = pk2(bflo(w.y) * e, bfhi(w.y) * e); o.z = pk2(bflo(w.z) * e, bfhi(w.z) * e); o.w = pk2(bflo(w.w) * e, bfhi(w.w) * e);
                *(v4u*)(QDg + (size_t)item * 8192 + c * 128 + ch * 8) = o; }
#pragma unroll
            for (int k = 0; k < 4; ++k) { const int i = t2 + 256 * k, d = i & 127, c8 = (i >> 7) * 8; float v[8];
#pragma unroll
                for (int q = 0; q < 8; ++q) v[q] = bf2f(*(LAS const unsigned short*)(Kb + (c8 + q) * KB_PITCH + d * 2)) * __expf(gl - gcs[c8 + q]);
                v4u o; o.x = pk2(v[0], v[1]); o.y = pk2(v[2], v[3]); o.z = pk2(v[4], v[5]); o.w = pk2(v[6], v[7]);
                *(v4u*)(KTg + (size_t)item * 8192 + d * 64 + c8) = o; }
        }
        __syncthreads();
        for (int i = tid; i < 64 * 64; i += NTHREADS) { const int c = i >> 6, j4 = (i & 63) * 4; const f32x4 v = *(LAS const f32x4*)(Rs + c * 256 + j4);
            if (j4 < 128) *(f32x4*)(GU + (size_t)item * 8192 + c * 128 + j4) = v;
            else { v2u o; o.x = pk2(-v.x, -v.y); o.y = pk2(-v.z, -v.w); *(v2u*)(NWg + (size_t)item * 8192 + c * 128 + (j4 - 128)) = o; } }
        __syncthreads();
    }
}

typedef float f32x4v __attribute__((ext_vector_type(4)));
constexpr int SC_NW = 0, SC_QD = 17408, SC_KT = 34816, SC_QK = 34816 + 18432, SC_BUF = 34816 + 18432 + 9216;
__device__ __forceinline__ bf16x8v afrag(LAS const unsigned char* p) {
    const v2u a = *(LAS const v2u*)p, b = *(LAS const v2u*)(p + 32); v4u w; w.x = a.x; w.y = a.y; w.z = b.x; w.w = b.y; return __builtin_bit_cast(bf16x8v, w);
}
__device__ __forceinline__ bf16x8v bfrag(const f32x4v& t0, const f32x4v& t1) { v4u w; w.x = cvtpk(t0[0], t0[1]); w.y = cvtpk(t0[2], t0[3]); w.z = cvtpk(t1[0], t1[1]); w.w = cvtpk(t1[2], t1[3]); return __builtin_bit_cast(bf16x8v, w); }
__device__ __forceinline__ void phase_gdn_scan_mfma(const Ctx& C) {
    if (C.bid >= 32) return;
    const int bh = C.bid, tid = C.tid, lane = C.lane, w = C.wave, fr = lane & 15, g = lane >> 4;
    const bf16* NWg = (const bf16*)(C.ws + WS_NW); const bf16* QDg = (const bf16*)(C.ws + WS_QD); const bf16* KTg = (const bf16*)(C.ws + WS_KT); const bf16* QKg = (const bf16*)(C.ws + WS_QKB);
    const float* GU = (const float*)(C.ws + WS_GU); float* GO = (float*)(C.ws + WS_GO); const float* EGL = (const float*)(C.ws + WS_EGL);
    int soff[7]; const bf16* sptr[7];
#pragma unroll
    for (int k = 0; k < 7; ++k) { const int i = tid + 512 * (k & 1);
        if (k < 2) { soff[k] = SC_NW + (i >> 4) * 272 + (i & 15) * 16; sptr[k] = NWg + i * 8; }
        else if (k < 4) { soff[k] = SC_QD + (i >> 4) * 272 + (i & 15) * 16; sptr[k] = QDg + i * 8; }
        else if (k < 6) { soff[k] = SC_KT + (i >> 3) * 144 + (i & 7) * 16; sptr[k] = KTg + i * 8; }
        else { soff[k] = SC_QK + (tid >> 3) * 144 + (tid & 7) * 16; sptr[k] = QKg + tid * 8; } }
    f32x4v S[8];
#pragma unroll
    for (int i = 0; i < 8; ++i) S[i] = (f32x4v){0.f, 0.f, 0.f, 0.f};
    v4u st[7];
    { const size_t ib = (size_t)bh * 32;
#pragma unroll
      for (int k = 0; k < 7; ++k) st[k] = *(const v4u*)(sptr[k] + ib * (k < 6 ? 8192 : 4096));
#pragma unroll
      for (int k = 0; k < 7; ++k) *(LAS v4u*)(C.lds + soff[k]) = st[k]; }
    f32x4v un[4];
    { const float* up = GU + (size_t)bh * 32 * 8192 + (4 * g) * 128 + 16 * w + fr;
#pragma unroll
      for (int ct = 0; ct < 4; ++ct)
#pragma unroll
          for (int r = 0; r < 4; ++r) un[ct][r] = up[(16 * ct + r) * 128]; }
    float egn = EGL[bh * 32];
    __syncthreads();
    for (int n = 0; n < 32; ++n) {
        const size_t item = (size_t)bh * 32 + n;
        LAS const unsigned char* B = C.lds + (n & 1) * SC_BUF;
        const bool more = n < 31;
        f32x4v Vp[4]; const float eg = egn;
#pragma unroll
        for (int ct = 0; ct < 4; ++ct) Vp[ct] = un[ct];
        if (more) {
#pragma unroll
            for (int k = 0; k < 7; ++k) st[k] = *(const v4u*)(sptr[k] + (item + 1) * (k < 6 ? 8192 : 4096));
            const float* up = GU + (item + 1) * 8192 + (4 * g) * 128 + 16 * w + fr;
#pragma unroll
            for (int ct = 0; ct < 4; ++ct)
#pragma unroll
                for (int r = 0; r < 4; ++r) un[ct][r] = up[(16 * ct + r) * 128];
            egn = EGL[item + 1];
        }
        bf16x8v sf[4];
#pragma unroll
        for (int ks = 0; ks < 4; ++ks) sf[ks] = bfrag(S[2 * ks], S[2 * ks + 1]);
        LAS const unsigned char* pa = B + SC_NW + fr * 272 + 8 * g;
#pragma unroll
        for (int ct = 0; ct < 4; ++ct)
#pragma unroll
            for (int ks = 0; ks < 4; ++ks) Vp[ct] = __builtin_amdgcn_mfma_f32_16x16x32_bf16(afrag(pa + ct * 16 * 272 + ks * 64), sf[ks], Vp[ct], 0, 0, 0);
        bf16x8v vf[2];
#pragma unroll
        for (int k2 = 0; k2 < 2; ++k2) vf[k2] = bfrag(Vp[2 * k2], Vp[2 * k2 + 1]);
        LAS const unsigned char* pq = B + SC_QD + fr * 272 + 8 * g; LAS const unsigned char* pk = B + SC_QK + fr * 144 + 8 * g;
        float* op = GO + item * 8192 + (4 * g) * 128 + 16 * w + fr;
#pragma unroll
        for (int ct = 0; ct < 4; ++ct) { f32x4v o = (f32x4v){0.f, 0.f, 0.f, 0.f};
#pragma unroll
            for (int ks = 0; ks < 4; ++ks) o = __builtin_amdgcn_mfma_f32_16x16x32_bf16(afrag(pq + ct * 16 * 272 + ks * 64), sf[ks], o, 0, 0, 0);
#pragma unroll
            for (int k2 = 0; k2 < 2; ++k2) o = __builtin_amdgcn_mfma_f32_16x16x32_bf16(afrag(pk + ct * 16 * 144 + k2 * 64), vf[k2], o, 0, 0, 0);
#pragma unroll
            for (int r = 0; r < 4; ++r) op[(16 * ct + r) * 128] = o[r]; }
        LAS const unsigned char* pt = B + SC_KT + fr * 144 + 8 * g;
#pragma unroll
        for (int dt = 0; dt < 8; ++dt) { f32x4v s = S[dt] * eg;
#pragma unroll
            for (int k2 = 0; k2 < 2; ++k2) s = __builtin_amdgcn_mfma_f32_16x16x32_bf16(afrag(pt + dt * 16 * 144 + k2 * 64), vf[k2], s, 0, 0, 0);
            S[dt] = s; }
        if (more) {
            LAS unsigned char* Bn = C.lds + ((n + 1) & 1) * SC_BUF;
#pragma unroll
            for (int k = 0; k < 7; ++k) *(LAS v4u*)(Bn + soff[k]) = st[k];
        }
        __syncthreads();
    }
}

#define RLX_AGENT __ATOMIC_RELAXED, __HIP_MEMORY_SCOPE_AGENT
#define XB_TMO      128
#define XB_XCNT(j)  (256  + 64 * (j))
#define XB_XSUB(j)  (1280 + 64 * (j))
#define XB_XGEN(j)  (2304 + 64 * (j))
#define XB_TOP      3328
#define XB_TOPGEN   3392
#define XCD_BAR_WORDS 3456
#define XB_SPIN_CAP (1u << 18)

__device__ __forceinline__ unsigned xb_ld(unsigned* p)              { return __hip_atomic_load(p, __ATOMIC_RELAXED, __HIP_MEMORY_SCOPE_AGENT); }
__device__ __forceinline__ unsigned xb_add(unsigned* p, unsigned v) { return __hip_atomic_fetch_add(p, v, __ATOMIC_RELAXED, __HIP_MEMORY_SCOPE_AGENT); }
__device__ __forceinline__ unsigned xb_xcc_id() { return (unsigned)__builtin_amdgcn_s_getreg((3 << 11) | 20) & 0xFu; }
#define XB_SPIN(cond, bar) do { unsigned _sp = 0; while (cond) { __builtin_amdgcn_s_sleep(1); \
    if ((++_sp & 255u) == 0u) { if (xb_ld(&(bar)[XB_TMO])) break; if (_sp > XB_SPIN_CAP) { atomicAdd(&(bar)[XB_TMO], 1u); break; } } } } while (0)

struct XcdBarrier {
    unsigned* bar; unsigned x;
    volatile LAS unsigned* st;
};

__device__ __forceinline__ XcdBarrier xcd_barrier_post(unsigned* bar, volatile LAS unsigned* st) {
    XcdBarrier b; b.bar = bar; b.x = xb_xcc_id(); b.st = st;
    if (threadIdx.x == 0) (void)xb_add(&bar[XB_XCNT(b.x)], 1u);
    return b;
}
__device__ __forceinline__ void xcd_barrier_complete(unsigned* bar, unsigned x, unsigned& nloc, unsigned& nx) {
    const unsigned G = gridDim.x * gridDim.y * gridDim.z;
    unsigned sum, cnt, mine, sp = 0u;
    for (;;) {
        sum = 0u; cnt = 0u; mine = 0u;
#pragma unroll
        for (unsigned j = 0; j < 16; ++j) { const unsigned c = xb_ld(&bar[XB_XCNT(j)]); sum += c; cnt += (c > 0u) ? 1u : 0u; mine = (j == x) ? c : mine; }
        if (sum == G) break;
        __builtin_amdgcn_s_sleep(1);
        if ((++sp & 255u) == 0u) { if (xb_ld(&bar[XB_TMO])) break; if (sp > XB_SPIN_CAP) { atomicAdd(&bar[XB_TMO], 1u); break; } }
    }
    nloc = mine > 0u ? mine : 1u; nx = cnt > 0u ? cnt : 1u;
}

__device__ __forceinline__ void xcd_barrier(const XcdBarrier& b) {
    asm volatile("s_waitcnt vmcnt(0)" ::: "memory");
    __syncthreads();
    if (threadIdx.x == 0) {
        unsigned* bar = b.bar;
        __builtin_amdgcn_s_waitcnt(0);
        unsigned nloc = b.st[0], nx = b.st[1];
        if (nloc == 0u) { xcd_barrier_complete(bar, b.x, nloc, nx); b.st[0] = nloc; b.st[1] = nx; }
        const unsigned old = xb_add(&bar[XB_XSUB(b.x)], 1u);
        const unsigned gen = old / nloc;
        if (old + 1u == (gen + 1u) * nloc) {
            __builtin_amdgcn_fence(__ATOMIC_RELEASE, "agent");
            asm volatile("s_waitcnt vmcnt(0)" ::: "memory");
            const unsigned og = xb_add(&bar[XB_TOP], 1u);
            const unsigned tg = og / nx;
            if (og + 1u == (tg + 1u) * nx) xb_add(&bar[XB_TOPGEN], 1u);
            else XB_SPIN(xb_ld(&bar[XB_TOPGEN]) == tg, bar);
            __builtin_amdgcn_fence(__ATOMIC_ACQUIRE, "agent");
            xb_add(&bar[XB_XGEN(b.x)], 1u);
            asm volatile("s_waitcnt vmcnt(0)" ::: "memory");
        } else {
            XB_SPIN(xb_ld(&bar[XB_XGEN(b.x)]) == gen, bar);
            __builtin_amdgcn_fence(__ATOMIC_ACQUIRE, "agent");
            asm volatile("s_waitcnt vmcnt(0)" ::: "memory");
        }
    }
    __syncthreads();
}


template <bool COOP>
__global__ void __launch_bounds__(NTHREADS, 2) fwd(Args args) {
    extern __shared__ __attribute__((aligned(16))) unsigned char lds_raw[];
    if (threadIdx.x < 32) ((LAS unsigned*)((LAS unsigned char*)lds_raw + MISC_OFF))[threadIdx.x] = 0u;
    __syncthreads();
    XcdBarrier bar = xcd_barrier_post((unsigned*)(args.ws + WS_CTL) + CW_BAR, (volatile LAS unsigned*)((LAS unsigned char*)lds_raw + MISC_OFF) + 8);
    if (COOP) cg::this_grid().sync();
    for (int ph = args.ph_lo; ph < args.ph_hi; ++ph) {
        int tid_ = threadIdx.x; asm volatile("" : "+v"(tid_));
        unsigned char* ws_ = args.ws; asm volatile("" : "+s"(ws_));
        float* out_ = args.out; asm volatile("" : "+s"(out_));
        unsigned ldsb_ = 0; asm volatile("" : "+s"(ldsb_));
        Ctx C;
        C.lds = (LAS unsigned char*)lds_raw + ldsb_; C.ws = ws_; C.in = args.in; C.X = out_;
        C.tid = tid_; C.lane = C.tid & 63; C.wave = __builtin_amdgcn_readfirstlane(C.tid >> 6);
        C.G = gridDim.x; C.bid = blockIdx.x; C.gw = C.bid * NWAVES + C.wave; C.ngw = C.G * NWAVES;
        if (ph == 0) { phase_rows(C, 0, args.in[0], nullptr, nullptr); }
        else {
            const int l = (ph - 1) / PH_PER_LAYER, sp = (ph - 1) % PH_PER_LAYER;
#ifndef PHMASK
#define PHMASK 0xffff
#endif
#define PHON(k) ((PHMASK >> (k)) & 1)
#ifndef NAIVE_CHUNK
#define NAIVE_CHUNK 0
#endif
#ifndef NAIVE_DSW
#define NAIVE_DSW 0
#endif
#ifndef NAIVE_DIFF
#define NAIVE_DIFF 0
#endif
#ifndef REPMASK
#define REPMASK 0
#endif
#define REPON(k) ((REPMASK >> (k)) & 1)
            switch (sp) {
            case 0: if (PHON(0)) phase_wconv(C, l); break;
            case 1: case 10: if (PHON(1)) {
                if (sp == 1) phase_bg(C, l);
                const bf16* Bt = (const bf16*)(C.ws + (sp == 1 ? WS_WIN : WS_WUP)); bf16* Op = (bf16*)(C.ws + (sp == 1 ? WS_PROJ : WS_U)); int N = (sp == 1) ? NIN : NUP;
                asm volatile("" : "+s"(Bt), "+s"(Op), "+s"(N));
                pg8::Gemm g{(const bf16*)(C.ws + WS_XB), Bt, M, N, DM}; pg8::EpiBf16 E{Op, N};
                pg8::StaticOrder S; S.init(M, N, C.G, C.bid);
                pg8::gemm_phase<pg8::EpiBf16, pg8::StaticOrder, true, false>(C.lds, g, S, E);
            } break;
            case 2: break;
            case 3: if (PHON(3)) { phase_gdn_chunk_mfma(C, l); } break;
            case 4: if (PHON(4)) { phase_gdn_scan_mfma(C); } break;
            case 5: if (PHON(5)) phase_gdn_out(C, l); break;
            case 6: if (PHON(6)) { if (NAIVE_DSW) phase_dsw(C); else phase_dsw_mfma(C); } break;
            case 7: if (PHON(7)) { if (NAIVE_DIFF) phase_diff(C, l); else phase_diff_mfma(C, l); } break;
            case 8: case 12: if (PHON(8)) {
                const bf16* Ap = (const bf16*)(C.ws + (sp == 8 ? WS_MIX : WS_H)); const bf16* Bt = (const bf16*)(C.ws + (sp == 8 ? WS_WOUT : WS_WDN)); int K = (sp == 8) ? DM : KDN;
                asm volatile("" : "+s"(Ap), "+s"(Bt), "+s"(K));
                pg8::Gemm g{Ap, Bt, M, DM, K}; pg8::EpiRes E{C.X, DM, ALPHA};
                pg8::StaticOrder S; S.init(M, DM, C.G, C.bid);
                pg8::gemm_phase<pg8::EpiRes, pg8::StaticOrder, true, false>(C.lds, g, S, E);
            } break;
            case 9: if (PHON(9)) phase_rows(C, 1, C.X, args.in[9] + l * DM, args.in[10] + l * DM); break;
            case 11: if (PHON(11)) { phase_glu(C, l); if (REPON(11)) phase_glu(C, l); } break;
            case 13: if (PHON(9)) phase_rows(C, 1, C.X, args.in[14] + l * DM, args.in[15] + l * DM); break;
            }
        }
        if (COOP && ph + 1 < args.ph_hi) { xcd_barrier(bar); }
    }
}

extern "C" void kernel_launch(void* const* d_in, const int* in_sizes, int n_in, void* d_out, int out_size, void* d_ws, size_t ws_size, hipStream_t stream) {
    static int grid = 0;
    if (grid == 0) {
        if (n_in != 16 || out_size != M * DM || ws_size < WS_END) { fprintf(stderr, "kernel_launch: unexpected sizes n_in %d out %d ws %zu\n", n_in, out_size, ws_size); grid = -1; return; }
        int dev = 0, cus = 0, per_cu = 0;
        (void)hipGetDevice(&dev); (void)hipDeviceGetAttribute(&cus, hipDeviceAttributeMultiprocessorCount, dev);
        (void)hipFuncSetAttribute((const void*)fwd<MK_ONE_LAUNCH != 0>, hipFuncAttributeMaxDynamicSharedMemorySize, LDS_BYTES);
        (void)hipOccupancyMaxActiveBlocksPerMultiprocessor(&per_cu, (const void*)fwd<MK_ONE_LAUNCH != 0>, NTHREADS, LDS_BYTES);
        if (per_cu < 1) per_cu = 1;
        (void)hipGetLastError();
        grid = cus;
    }
    if (grid < 0) return;
    (void)hipMemsetAsync((char*)d_ws + WS_CTL, 0, CTL_ZERO_BYTES, stream);
    Args a{};
    for (int i = 0; i < 16; ++i) a.in[i] = (const float*)d_in[i];
    a.out = (float*)d_out; a.ws = (unsigned char*)d_ws;
#if MK_ONE_LAUNCH
    a.ph_lo = 0; a.ph_hi = N_PHASES;
    void* kargs[] = {&a};
    hipError_t e = hipLaunchCooperativeKernel((const void*)fwd<true>, dim3(grid), dim3(NTHREADS), kargs, LDS_BYTES, stream);
    if (e != hipSuccess) fprintf(stderr, "cooperative launch failed: %s (grid %d)\n", hipGetErrorString(e), grid);
#else
    for (int ph = 0; ph < N_PHASES; ++ph) { a.ph_lo = ph; a.ph_hi = ph + 1; hipLaunchKernelGGL(fwd<false>, dim3(grid), dim3(NTHREADS), LDS_BYTES, stream, a); }
#endif
}
```
